# Optimizing an MI355X kernel written in HIP

```python
import math
import numpy as np
import jax
import jax.numpy as jnp
from jax import lax

D_MODEL = 1024
BATCH = 16
SEQ = 2048
DEPTH = 1

HEAD_DIM = 64
ROPE_DIM = HEAD_DIM // 4
ROPE_THETA = 500000.0
DIFF_HEADS = 4
DIFF_V_DIM = 2 * HEAD_DIM
NSA_HEADS = 8
NSA_KV_HEADS = 2
NSA_GROUP = NSA_HEADS // NSA_KV_HEADS
N_BRANCH = 3
CMP_BLOCK = 32
CMP_STRIDE = 16
CMP_HIDDEN = 4 * HEAD_DIM
SEL_BLOCK = 64
SEL_TOP_N = 16
WINDOW = 512
D_FF = 2816
Q_BLOCK = 128
SEL_Q_CHUNK = 64
MIX_WIDTH = DIFF_HEADS * DIFF_V_DIM + NSA_HEADS * HEAD_DIM
IN_SIZES = (DIFF_HEADS * 2 * HEAD_DIM, DIFF_HEADS * 2 * HEAD_DIM, DIFF_HEADS * DIFF_V_DIM,
            NSA_HEADS * HEAD_DIM) + (NSA_KV_HEADS * HEAD_DIM,) * 6 + (NSA_HEADS * N_BRANCH,)
IN_WIDTH = sum(IN_SIZES)
EPS = 1e-6
NEG_INF = -1e30
FORCE_SCORE = 1e9

kernel_name = "hymba_diffattn_nsa_macaron_layer"


def rms_norm(x, g):
    xf = x.astype(jnp.float32)
    y = xf * lax.rsqrt(jnp.mean(xf * xf, axis=-1, keepdims=True) + EPS)
    return (y * g.astype(jnp.float32)).astype(x.dtype)


def rope_tables(S):
    pos = jnp.arange(S, dtype=jnp.float32)
    inv = ROPE_THETA ** (-jnp.arange(0, ROPE_DIM, 2, dtype=jnp.float32) / ROPE_DIM)
    ang = pos[:, None] * inv[None, :]
    return jnp.cos(ang), jnp.sin(ang)


def partial_rope(x, cos, sin):
    xr = x[..., :ROPE_DIM].astype(jnp.float32)
    x1, x2 = xr[..., :ROPE_DIM // 2], xr[..., ROPE_DIM // 2:]
    rot = jnp.concatenate([x1 * cos - x2 * sin, x2 * cos + x1 * sin], axis=-1)
    return jnp.concatenate([rot.astype(x.dtype), x[..., ROPE_DIM:]], axis=-1)


def swiglu(h, w_gate, w_up, w_down):
    return (jax.nn.silu(h @ w_gate) * (h @ w_up)) @ w_down


def diff_attention(q, k, v, lam, subln_g, lambda_init):
    B, Hd, _, S, dh = q.shape
    nb = S // Q_BLOCK
    scale = dh ** -0.5
    qb = q.reshape(B, Hd, 2, nb, Q_BLOCK, dh).transpose(3, 0, 1, 2, 4, 5)
    kpos = jnp.arange(S)

    def block(args):
        qi, i = args
        s = jnp.einsum('bhmqd,bhmkd->bhmqk', qi, k).astype(jnp.float32) * scale
        qpos = i * Q_BLOCK + jnp.arange(Q_BLOCK)
        s = jnp.where(kpos[None, :] <= qpos[:, None], s, NEG_INF)
        p = jax.nn.softmax(s, axis=-1)
        a = p[:, :, 0] - lam * p[:, :, 1]
        return jnp.einsum('bhqk,bhkd->bhqd', a.astype(v.dtype), v)

    o = lax.map(block, (qb, jnp.arange(nb)))
    o = o.transpose(1, 2, 0, 3, 4).reshape(B, Hd, S, 2 * dh)
    o = rms_norm(o, subln_g) * (1.0 - lambda_init)
    return o.transpose(0, 2, 1, 3).reshape(B, S, Hd * 2 * dh)


def compress(x, pe, w1, w2):
    B, G, S, dh = x.shape
    r = CMP_BLOCK // CMP_STRIDE
    nc = S // CMP_STRIDE - r + 1
    sub = x.reshape(B, G, S // CMP_STRIDE, CMP_STRIDE, dh)
    blocks = jnp.concatenate([sub[:, :, j:j + nc] for j in range(r)], axis=3)
    blocks = (blocks + pe).reshape(B, G, nc, CMP_BLOCK * dh)
    return jax.nn.gelu(blocks @ w1) @ w2


def sel_overlap(nc, n_sel):
    cs = np.arange(nc)[:, None] * CMP_STRIDE
    ss = np.arange(n_sel)[None, :] * SEL_BLOCK
    ov = np.minimum(cs + CMP_BLOCK, ss + SEL_BLOCK) - np.maximum(cs, ss)
    return jnp.asarray(np.clip(ov, 0, None) / CMP_BLOCK, dtype=jnp.float32)


def nsa_attention(q, k_cmp, v_cmp, k_sel, v_sel, k_win, v_win, gates,
                  pe_k, wk1, wk2, pe_v, wv1, wv2):
    B, H, S, dh = q.shape
    G, Hg = NSA_KV_HEADS, NSA_GROUP
    scale = dh ** -0.5
    qg = q.reshape(B, G, Hg, S, dh)
    t = jnp.arange(S)

    kc = compress(k_cmp, pe_k, wk1, wk2)
    vc = compress(v_cmp, pe_v, wv1, wv2)
    nc = kc.shape[2]
    cend = jnp.arange(nc) * CMP_STRIDE + CMP_BLOCK - 1
    cvalid = cend[None, :] <= t[:, None]
    s = jnp.einsum('bghsd,bgcd->bghsc', qg, kc).astype(jnp.float32) * scale
    p_cmp = jnp.where(cvalid, jax.nn.softmax(jnp.where(cvalid, s, NEG_INF), axis=-1), 0.0)
    o_cmp = jnp.einsum('bghsc,bgcd->bghsd', p_cmp.astype(vc.dtype), vc)

    n_sel = S // SEL_BLOCK
    top_n = min(SEL_TOP_N, n_sel)
    imp = jnp.einsum('bghsc,cj->bgsj', p_cmp, sel_overlap(nc, n_sel))
    blk = jnp.arange(n_sel)[None, :]
    cur = (t // SEL_BLOCK)[:, None]
    causal_blk = blk * SEL_BLOCK <= t[:, None]
    forced = (blk == 0) | ((blk <= cur) & (blk >= cur - 1))
    imp = jnp.where(forced, FORCE_SCORE, jnp.where(causal_blk, imp, -1.0))
    _, idx = lax.top_k(imp, top_n)

    kb = k_sel.reshape(B, G, n_sel, SEL_BLOCK, dh)
    vb = v_sel.reshape(B, G, n_sel, SEL_BLOCK, dh)
    C = SEL_Q_CHUNK
    nq = S // C
    q_c = qg.reshape(B, G, Hg, nq, C, dh).transpose(3, 0, 1, 2, 4, 5)
    idx_c = idx.reshape(B, G, nq, C, top_n).transpose(2, 0, 1, 3, 4)
    bi = jnp.arange(B)[:, None, None, None]
    gi = jnp.arange(G)[None, :, None, None]

    def sel_chunk(args):
        qi, ii, c = args
        ks = kb[bi, gi, ii]
        vs = vb[bi, gi, ii]
        s = jnp.einsum('bghqd,bgqnld->bghqnl', qi, ks).astype(jnp.float32) * scale
        kpos = ii[..., None] * SEL_BLOCK + jnp.arange(SEL_BLOCK)
        qpos = c * C + jnp.arange(C)
        mask = kpos <= qpos[None, None, :, None, None]
        s = jnp.where(mask[:, :, None], s, NEG_INF).reshape(B, G, Hg, C, top_n * SEL_BLOCK)
        p = jax.nn.softmax(s, axis=-1).reshape(B, G, Hg, C, top_n, SEL_BLOCK)
        return jnp.einsum('bghqnl,bgqnld->bghqd', p.astype(vs.dtype), vs)

    o_sel = lax.map(sel_chunk, (q_c, idx_c, jnp.arange(nq)))
    o_sel = o_sel.transpose(1, 2, 3, 0, 4, 5).reshape(B, G, Hg, S, dh)

    nb = S // Q_BLOCK
    span = WINDOW + Q_BLOCK
    kp = jnp.pad(k_win, ((0, 0), (0, 0), (WINDOW, 0), (0, 0)))
    vp = jnp.pad(v_win, ((0, 0), (0, 0), (WINDOW, 0), (0, 0)))
    q_w = qg.reshape(B, G, Hg, nb, Q_BLOCK, dh).transpose(3, 0, 1, 2, 4, 5)

    def win_block(args):
        qi, i = args
        start = i * Q_BLOCK
        ks = lax.dynamic_slice_in_dim(kp, start, span, axis=2)
        vs = lax.dynamic_slice_in_dim(vp, start, span, axis=2)
        s = jnp.einsum('bghqd,bgkd->bghqk', qi, ks).astype(jnp.float32) * scale
        qpos = start + jnp.arange(Q_BLOCK)
        kpos = start - WINDOW + jnp.arange(span)
        d = qpos[:, None] - kpos[None, :]
        mask = (d >= 0) & (d < WINDOW) & (kpos[None, :] >= 0)
        p = jax.nn.softmax(jnp.where(mask, s, NEG_INF), axis=-1)
        return jnp.einsum('bghqk,bgkd->bghqd', p.astype(vs.dtype), vs)

    o_win = lax.map(win_block, (q_w, jnp.arange(nb)))
    o_win = o_win.transpose(1, 2, 3, 0, 4, 5).reshape(B, G, Hg, S, dh)

    o = gates[..., 0:1] * o_cmp + gates[..., 1:2] * o_sel + gates[..., 2:3] * o_win
    return o.transpose(0, 3, 1, 2, 4).reshape(B, S, H * dh)


def hybrid_mixer(h, w_in, lambda_q1, lambda_k1, lambda_q2, lambda_k2, diff_subln,
                 cmp_pe_k, cmp_k_w1, cmp_k_w2, cmp_pe_v, cmp_v_w1, cmp_v_w2, w_out, lambda_init):
    B, S, _ = h.shape
    dh = HEAD_DIM
    cos, sin = rope_tables(S)
    pts = [int(v) for v in np.cumsum(IN_SIZES)[:-1]]
    dq, dk, dv, nq, kc, vc, ks, vs, kw, vw, gl = jnp.split(h @ w_in, pts, axis=-1)

    dq = partial_rope(dq.reshape(B, S, DIFF_HEADS, 2, dh).transpose(0, 2, 3, 1, 4), cos, sin)
    dk = partial_rope(dk.reshape(B, S, DIFF_HEADS, 2, dh).transpose(0, 2, 3, 1, 4), cos, sin)
    dv = dv.reshape(B, S, DIFF_HEADS, DIFF_V_DIM).transpose(0, 2, 1, 3)
    lq1, lk1 = lambda_q1.astype(jnp.float32), lambda_k1.astype(jnp.float32)
    lq2, lk2 = lambda_q2.astype(jnp.float32), lambda_k2.astype(jnp.float32)
    lam = jnp.exp(jnp.sum(lq1 * lk1)) - jnp.exp(jnp.sum(lq2 * lk2)) + lambda_init
    o_diff = diff_attention(dq, dk, dv, lam, diff_subln, lambda_init)

    def kv_heads(a):
        return a.reshape(B, S, NSA_KV_HEADS, dh).transpose(0, 2, 1, 3)
    nq = partial_rope(nq.reshape(B, S, NSA_HEADS, dh).transpose(0, 2, 1, 3), cos, sin)
    gates = jax.nn.sigmoid(gl.reshape(B, S, NSA_HEADS, N_BRANCH)).transpose(0, 2, 1, 3)
    gates = gates.reshape(B, NSA_KV_HEADS, NSA_GROUP, S, N_BRANCH)
    o_nsa = nsa_attention(nq, kv_heads(kc), kv_heads(vc),
                          partial_rope(kv_heads(ks), cos, sin), kv_heads(vs),
                          partial_rope(kv_heads(kw), cos, sin), kv_heads(vw), gates,
                          cmp_pe_k, cmp_k_w1, cmp_k_w2, cmp_pe_v, cmp_v_w1, cmp_v_w2)

    return jnp.concatenate([o_diff, o_nsa], axis=-1) @ w_out


def setup_inputs(seed: int = 0) -> dict:
    key = jax.random.key(seed)
    ks = jax.random.split(key, 26)
    f32 = jnp.float32
    L = DEPTH

    def w(k, shape, fan_in):
        return jax.random.normal(k, shape, f32) * fan_in ** -0.5

    def gain(k, n):
        return 1.0 + 0.1 * jax.random.normal(k, (L, n), f32)

    return {
        'x': jax.random.normal(ks[0], (BATCH, SEQ, D_MODEL), f32),
        'ff1_norm_pre': gain(ks[1], D_MODEL),
        'ff1_w_gate': w(ks[2], (L, D_MODEL, D_FF), D_MODEL),
        'ff1_w_up': w(ks[3], (L, D_MODEL, D_FF), D_MODEL),
        'ff1_w_down': w(ks[4], (L, D_FF, D_MODEL), D_FF),
        'ff1_norm_post': gain(ks[5], D_MODEL),
        'mix_norm_pre': gain(ks[6], D_MODEL),
        'w_in': w(ks[7], (L, D_MODEL, IN_WIDTH), D_MODEL),
        'lambda_q1': 0.1 * jax.random.normal(ks[8], (L, HEAD_DIM), f32),
        'lambda_k1': 0.1 * jax.random.normal(ks[9], (L, HEAD_DIM), f32),
        'lambda_q2': 0.1 * jax.random.normal(ks[10], (L, HEAD_DIM), f32),
        'lambda_k2': 0.1 * jax.random.normal(ks[11], (L, HEAD_DIM), f32),
        'diff_subln': gain(ks[12], DIFF_V_DIM),
        'cmp_pe_k': 0.1 * jax.random.normal(ks[13], (L, CMP_BLOCK, HEAD_DIM), f32),
        'cmp_k_w1': w(ks[14], (L, CMP_BLOCK * HEAD_DIM, CMP_HIDDEN), CMP_BLOCK * HEAD_DIM),
        'cmp_k_w2': w(ks[15], (L, CMP_HIDDEN, HEAD_DIM), CMP_HIDDEN),
        'cmp_pe_v': 0.1 * jax.random.normal(ks[16], (L, CMP_BLOCK, HEAD_DIM), f32),
        'cmp_v_w1': w(ks[17], (L, CMP_BLOCK * HEAD_DIM, CMP_HIDDEN), CMP_BLOCK * HEAD_DIM),
        'cmp_v_w2': w(ks[18], (L, CMP_HIDDEN, HEAD_DIM), CMP_HIDDEN),
        'w_out': w(ks[19], (L, MIX_WIDTH, D_MODEL), MIX_WIDTH),
        'mix_norm_post': gain(ks[20], D_MODEL),
        'ff2_norm_pre': gain(ks[21], D_MODEL),
        'ff2_w_gate': w(ks[22], (L, D_MODEL, D_FF), D_MODEL),
        'ff2_w_up': w(ks[23], (L, D_MODEL, D_FF), D_MODEL),
        'ff2_w_down': w(ks[24], (L, D_FF, D_MODEL), D_FF),
        'ff2_norm_post': gain(ks[25], D_MODEL),
    }


def reference(x, ff1_norm_pre, ff1_w_gate, ff1_w_up, ff1_w_down, ff1_norm_post,
              mix_norm_pre, w_in, lambda_q1, lambda_k1, lambda_q2, lambda_k2, diff_subln,
              cmp_pe_k, cmp_k_w1, cmp_k_w2, cmp_pe_v, cmp_v_w1, cmp_v_w2, w_out, mix_norm_post,
              ff2_norm_pre, ff2_w_gate, ff2_w_up, ff2_w_down, ff2_norm_post):
    for l in range(DEPTH):
        lambda_init = 0.8 - 0.6 * math.exp(-0.3 * l)
        h = swiglu(rms_norm(x, ff1_norm_pre[l]), ff1_w_gate[l], ff1_w_up[l], ff1_w_down[l])
        x = x + 0.5 * rms_norm(h, ff1_norm_post[l])
        h = hybrid_mixer(rms_norm(x, mix_norm_pre[l]), w_in[l], lambda_q1[l], lambda_k1[l],
                         lambda_q2[l], lambda_k2[l], diff_subln[l], cmp_pe_k[l], cmp_k_w1[l],
                         cmp_k_w2[l], cmp_pe_v[l], cmp_v_w1[l], cmp_v_w2[l], w_out[l], lambda_init)
        x = x + rms_norm(h, mix_norm_post[l])
        h = swiglu(rms_norm(x, ff2_norm_pre[l]), ff2_w_gate[l], ff2_w_up[l], ff2_w_down[l])
        x = x + 0.5 * rms_norm(h, ff2_norm_post[l])
    return x
```

```cpp
#include <hip/hip_runtime.h>
#include <hip/hip_cooperative_groups.h>
#include <cstdio>
#include <cstdint>
namespace cg = cooperative_groups;
namespace pg8 {
#define PG8_LAS __attribute__((address_space(3)))
typedef unsigned short bf16_t;
typedef short bf16x8 __attribute__((ext_vector_type(8)));
typedef float f32x4 __attribute__((ext_vector_type(4)));
typedef unsigned u32x4 __attribute__((ext_vector_type(4)));
constexpr int BM = 256, BK = 64, HALF = 128, HTB = HALF * BK * 2  , STAGE_BYTES = 8 * HTB, NXCD = 8, WGM = 8;

__host__ __device__ __forceinline__ int lds_byte(int r, int c) { const int st = (r >> 4) * 2 + (c >> 5), rr = r & 15, cc = c & 31, ob = rr * 64 + cc * 2; return st * 1024 + (ob ^ (((ob >> 9) & 1) << 5)); }
__host__ __device__ __forceinline__ void stage_rc(int b, int& R, int& C) { const int st = b / 1024, sb = b % 1024, swz = sb ^ (((sb >> 9) & 1) << 5); R = (st >> 1) * 16 + swz / 64; C = (st & 1) * 32 + (swz % 64) / 2; }
__host__ __device__ __forceinline__ int perm32(int rho) { const int n = rho >> 4, i = rho & 15; return 8 * (i >> 2) + 4 * n + (i & 3); }

struct Unit { int pm, pn; };
struct Gemm { const bf16_t* A; const bf16_t* Bt; int M, N, K; };

struct StaticOrder {
    int nM, nN, nwg, G, c;
    __host__ __device__ void init(int M, int N, int G_, int c_) { nM = M / BM; nN = N / BM; nwg = nM * nN; G = G_; c = c_; }
    __host__ __device__ bool next(int i, Unit& u) const {
        const long L = (long)i * G + c; if (L >= nwg) return false;
        int wgid = (int)L; { const int q = nwg / NXCD, r = nwg % NXCD, xcd = wgid % NXCD, off = wgid / NXCD; wgid = (xcd < r ? xcd * (q + 1) : r * (q + 1) + (xcd - r) * q) + off; }
        const int nig = WGM * nN, gid = wgid / nig, fm = gid * WGM, gsz = (nM - fm) < WGM ? (nM - fm) : WGM;
        u.pm = fm + ((wgid % nig) % gsz); u.pn = (wgid % nig) / gsz; return true;
    }
    __device__ __forceinline__ void a_ready(const Unit&) const {}
    __device__ __forceinline__ void done(const Unit&) const {}
};


typedef float f32x2 __attribute__((ext_vector_type(2)));
typedef __bf16 bf16x2v __attribute__((ext_vector_type(2)));
__device__ __forceinline__ unsigned cvt_pk_bf16(float lo, float hi) { f32x2 v = {lo, hi}; bf16x2v b = __builtin_convertvector(v, bf16x2v); return __builtin_bit_cast(unsigned, b); }
__device__ __forceinline__ unsigned short cvt_bf16(float x) { return (unsigned short)(cvt_pk_bf16(x, 0.f) & 0xffffu); }
__device__ __forceinline__ float fast_sigmoid(float x) { return __builtin_amdgcn_rcpf(1.f + __builtin_amdgcn_exp2f(-1.4426950408889634f * x)); }
__device__ __forceinline__ void st8(bf16_t* p, const float* v) { u32x4 w; w.x = cvt_pk_bf16(v[0], v[1]); w.y = cvt_pk_bf16(v[2], v[3]); w.z = cvt_pk_bf16(v[4], v[5]); w.w = cvt_pk_bf16(v[6], v[7]); *(u32x4*)p = w; }

struct EpiSwiglu {
    static constexpr bool PERM = true, AFTER_DRAIN = false;
    bf16_t* O; int ldc;
    __device__ __forceinline__ void operator()(const f32x4 (&acc)[2][2][4][2], const Unit& u, int wr, int wc, int fr, int fq) const {
        const int row0 = u.pm * BM + wr * 64 + fr, col0 = u.pn * HALF + wc * 32 + 8 * fq;
#pragma unroll
        for (int ai = 0; ai < 2; ++ai)
#pragma unroll
            for (int m = 0; m < 4; ++m) {
                float v[8];
#pragma unroll
                for (int n = 0; n < 2; ++n)
#pragma unroll
                    for (int e = 0; e < 4; ++e) { const float g = acc[ai][0][m][n][e], up = acc[ai][1][m][n][e]; v[4 * n + e] = g * fast_sigmoid(g) * up; }
                { u32x4 w; w.x = cvt_pk_bf16(v[0], v[1]); w.y = cvt_pk_bf16(v[2], v[3]); w.z = cvt_pk_bf16(v[4], v[5]); w.w = cvt_pk_bf16(v[6], v[7]); __builtin_nontemporal_store(w, (u32x4*)(O + (size_t)(row0 + ai * HALF + m * 16) * ldc + col0)); }
            }
    }
};

struct EpiStoreSS {
    static constexpr bool PERM = true, AFTER_DRAIN = false;
    bf16_t* O; float* SSP;
    __device__ __forceinline__ void operator()(const f32x4 (&acc)[2][2][4][2], const Unit& u, int wr, int wc, int fr, int fq) const {
        const int row0 = u.pm * BM + wr * 64 + fr, col0 = u.pn * BM + wc * 32 + 8 * fq;
#pragma unroll
        for (int ai = 0; ai < 2; ++ai)
#pragma unroll
            for (int m = 0; m < 4; ++m) {
                const int row = row0 + ai * HALF + m * 16; float ss = 0.f;
#pragma unroll
                for (int bj = 0; bj < 2; ++bj) {
                    float v[8];
#pragma unroll
                    for (int n = 0; n < 2; ++n)
#pragma unroll
                        for (int e = 0; e < 4; ++e) { v[4 * n + e] = acc[ai][bj][m][n][e]; ss += v[4 * n + e] * v[4 * n + e]; }
                    st8(O + (size_t)row * 1024 + col0 + bj * HALF, v);
                }
                ss += __shfl_xor(ss, 16); ss += __shfl_xor(ss, 32);
                if (fq == 0) SSP[(size_t)row * 16 + u.pn * 4 + wc] = ss;
            }
    }
};

struct EpiWin {
    static constexpr bool PERM = true, AFTER_DRAIN = false;
    bf16_t *DQ, *DK, *DVT, *NQ, *KV6;
    float* GATES; const float* ROPE;
    __device__ __forceinline__ void operator()(const f32x4 (&acc)[2][2][4][2], const Unit& u, int wr, int wc, int fr, int fq) const {
        const int row0 = u.pm * BM + wr * 64 + fr;
#pragma unroll
        for (int bj = 0; bj < 2; ++bj) {
            const int cb = u.pn * BM + bj * HALF;
            const int col0 = cb + wc * 32 + 8 * fq;
            int kind; bf16_t* base = nullptr; int heads = 1, dshift = 6, c = 0;
            if (cb < 512)       { kind = 1; base = DQ;  c = col0; }
            else if (cb < 1024) { kind = 1; base = DK;  c = col0 - 512; }
            else if (cb < 1536) { kind = 2; base = DVT; c = col0 - 1024; heads = 4; dshift = 7; }
            else if (cb < 2048) { kind = 1; base = NQ;  c = col0 - 1536; }
            else if (cb < 2816) { const int idx = (cb - 2048) >> 7; base = KV6 + (size_t)idx * (16 * 2 * 2048 * 64); c = col0 - cb; heads = 2; dshift = 6;
                                  kind = (idx == 2 || idx == 4) ? 1 : ((idx == 3 || idx == 5) ? 2 : 0); }
            else if (cb == 2816) { kind = 3; c = col0 - 2816; }
            else { kind = 4; }
            if (kind == 4) continue;
            const float qsc = (cb < 512 || (cb >= 1536 && cb < 2048)) ? 0.18033688011112042f : 1.f;
            const int d0 = c & ((1 << dshift) - 1), hd = c >> dshift;
            int slabs = 8;
            if (cb >= 2048) slabs = 2;
#pragma unroll
            for (int ai = 0; ai < 2; ++ai)
#pragma unroll
                for (int m = 0; m < 4; ++m) {
                    const int row = row0 + ai * HALF + m * 16, b = row >> 11, t = row & 2047;
                    float v[8];
#pragma unroll
                    for (int n = 0; n < 2; ++n)
#pragma unroll
                        for (int e = 0; e < 4; ++e) v[4 * n + e] = acc[ai][bj][m][n][e] * qsc;
                    if (kind == 1) {
                        float pv[8];
#pragma unroll
                        for (int e = 0; e < 8; ++e) pv[e] = __shfl_xor(v[e], 16);
                        if (d0 < 16) {
                            const f32x4* cs = (const f32x4*)(ROPE + t * 16);
                            const f32x4 c0 = cs[0], c1 = cs[1], s0 = cs[2], s1 = cs[3];
                            const float sg = (d0 == 0) ? -1.f : 1.f;
#pragma unroll
                            for (int e = 0; e < 4; ++e) { v[e] = v[e] * c0[e] + sg * pv[e] * s0[e]; v[4 + e] = v[4 + e] * c1[e] + sg * pv[4 + e] * s1[e]; }
                        }
                    }
                    if (kind <= 1) {
                        st8(base + (((size_t)(b * slabs + hd) * 2048 + t) << 6) + d0, v);
                    } else if (kind == 2) {
                        bf16_t* p = base + ((size_t)((b * heads + hd) << dshift) + d0) * 2048 + t;
#pragma unroll
                        for (int e = 0; e < 8; ++e) p[(size_t)e * 2048] = cvt_bf16(v[e]);
                    } else {
                        if (c < 24) {
#pragma unroll
                            for (int e = 0; e < 8; ++e) GATES[(size_t)row * 24 + c + e] = fast_sigmoid(v[e]);
                        }
                    }
                }
        }
    }
};

template <class Epi, class Sched, bool ALIGN_EPI = false, bool SP2 = false>
__device__ __forceinline__ void gemm_phase(PG8_LAS unsigned char* lds, const Gemm g, const Sched& S, const Epi& E) {
    int tid_l = threadIdx.x; asm volatile("" : "+v"(tid_l));
    const int tid = tid_l, wid = __builtin_amdgcn_readfirstlane(tid >> 6), lane = tid & 63, wr = wid >> 2, wc = wid & 3, fr = lane & 15, fq = lane >> 4;
    const int K = g.K, nt = K / BK;
    unsigned voffA[2], voffB[2];
#pragma unroll
    for (int i = 0; i < 2; ++i) { int R, C; stage_rc(tid * 16 + i * 8192, R, C); const int Rb = Epi::PERM ? ((R & ~31) + perm32(R & 31)) : R;
        voffA[i] = (unsigned)(R * K + C) * 2u; voffB[i] = (unsigned)(Rb * K + C) * 2u; }
    const size_t kstep = (size_t)(BK * 2);
    const size_t hstep = (size_t)HALF * K * 2;
    const size_t tstep = 2 * hstep;
    const unsigned ldsw = (unsigned)wid * 1024u;
    const int aoff = lds_byte(wr * 64 + fr, fq * 8), boff = lds_byte(wc * 32 + fr, fq * 8);
#define PG8_SA(b, h) (((b) * 2 + (h)) * HTB)
#define PG8_SB(b, h) ((4 + (b) * 2 + (h)) * HTB)
#define PG8_STAGE(bufoff, gbase, voff) do { _Pragma("unroll") for (int _i = 0; _i < 2; ++_i) \
        __builtin_amdgcn_global_load_lds((const unsigned*)((const char*)(gbase) + (voff)[_i]), (PG8_LAS unsigned*)(lds + (bufoff) + ldsw + _i * 8192), 16, 0, 0); } while (0)
#define PG8_LDA(dst, b, h) do { _Pragma("unroll") for (int m = 0; m < 4; ++m) _Pragma("unroll") for (int k = 0; k < 2; ++k) dst[m][k] = *(const PG8_LAS bf16x8*)(lds + PG8_SA(b, h) + aoff + m * 2048 + k * 1024); } while (0)
#define PG8_LDB(dst, b, h) do { _Pragma("unroll") for (int n = 0; n < 2; ++n) _Pragma("unroll") for (int k = 0; k < 2; ++k) dst[n][k] = *(const PG8_LAS bf16x8*)(lds + PG8_SB(b, h) + boff + n * 2048 + k * 1024); } while (0)
#define PG8_MMA(ai, bj, At, Bt) do { __builtin_amdgcn_s_setprio(1); _Pragma("unroll") for (int m = 0; m < 4; ++m) _Pragma("unroll") for (int n = 0; n < 2; ++n) _Pragma("unroll") for (int k = 0; k < 2; ++k) \
        acc[ai][bj][m][n] = __builtin_amdgcn_mfma_f32_16x16x32_bf16(Bt[n][k], At[m][k], acc[ai][bj][m][n], 0, 0, 0); __builtin_amdgcn_s_setprio(0); } while (0)
#define PG8_WAIT_V(n) asm volatile("s_waitcnt vmcnt(" #n ")" ::: "memory")
#define PG8_WAIT_L(n) asm volatile("s_waitcnt lgkmcnt(" #n ")" ::: "memory")
#define PG8_BAR __builtin_amdgcn_s_barrier()
#define PG8_SCHED __builtin_amdgcn_sched_barrier(0)
    Unit cur, nxt; int ui = 0;
    if (!S.next(0, cur)) return;
    f32x4 acc[2][2][4][2];
#pragma unroll
    for (int a = 0; a < 2; ++a)
#pragma unroll
        for (int b = 0; b < 2; ++b)
#pragma unroll
            for (int m = 0; m < 4; ++m)
#pragma unroll
                for (int n = 0; n < 2; ++n) acc[a][b][m][n] = (f32x4){0.f, 0.f, 0.f, 0.f};
    bf16x8 At[4][2], B0[2][2], B1[2][2];
    const char* cA = (const char*)g.A + (size_t)cur.pm * tstep; const char* cB = (const char*)g.Bt + (size_t)cur.pn * tstep;
    S.a_ready(cur);
    if constexpr (SP2) {
        PG8_STAGE(PG8_SB(0, 0), cB, voffB); PG8_STAGE(PG8_SB(0, 1), cB + hstep, voffB); PG8_STAGE(PG8_SA(0, 0), cA, voffA); PG8_STAGE(PG8_SA(0, 1), cA + hstep, voffA);
        if (wr == 1) PG8_BAR;
        PG8_WAIT_V(2); PG8_BAR;
        PG8_STAGE(PG8_SB(1, 0), cB + kstep, voffB); PG8_STAGE(PG8_SA(1, 0), cA + kstep, voffA); PG8_STAGE(PG8_SB(1, 1), cB + hstep + kstep, voffB);
        PG8_WAIT_V(6); PG8_BAR;
    } else {
        PG8_STAGE(PG8_SB(0, 0), cB, voffB); PG8_STAGE(PG8_SA(0, 0), cA, voffA); PG8_STAGE(PG8_SB(0, 1), cB + hstep, voffB); PG8_STAGE(PG8_SA(0, 1), cA + hstep, voffA);
        if (wr == 1) PG8_BAR;
        PG8_WAIT_V(4); PG8_BAR;
        PG8_STAGE(PG8_SB(1, 0), cB + kstep, voffB); PG8_STAGE(PG8_SA(1, 0), cA + kstep, voffA); PG8_STAGE(PG8_SB(1, 1), cB + hstep + kstep, voffB);
        PG8_WAIT_V(6); PG8_BAR;
    }
    for (;;) {
        const bool has_next = S.next(ui + 1, nxt);
        const char* nA = has_next ? (const char*)g.A + (size_t)nxt.pm * tstep : cA; const char* nB = has_next ? (const char*)g.Bt + (size_t)nxt.pn * tstep : cB;
        for (int t = 0; t < nt; t += 2) {
            const bool last = (t == nt - 2);
            const char* a1 = cA + (size_t)(t + 1) * kstep;
            const char* a2 = last ? nA : cA + (size_t)(t + 2) * kstep; const char* b2 = last ? nB : cB + (size_t)(t + 2) * kstep;
            const char* a3 = a2 + kstep; const char* b3 = b2 + kstep;
            if (last && has_next) S.a_ready(nxt);
            if constexpr (SP2) {
            PG8_LDB(B0, 0, 0); PG8_LDB(B1, 0, 1); PG8_SCHED; PG8_LDA(At, 0, 0); PG8_STAGE(PG8_SA(1, 1), a1 + hstep, voffA);
            PG8_WAIT_V(8); PG8_WAIT_L(0); PG8_BAR; PG8_MMA(0, 0, At, B0); PG8_MMA(0, 1, At, B1); PG8_BAR; PG8_SCHED;
            PG8_LDA(At, 0, 1); PG8_STAGE(PG8_SB(0, 0), b2, voffB); PG8_STAGE(PG8_SB(0, 1), b2 + hstep, voffB); PG8_STAGE(PG8_SA(0, 0), a2, voffA);
            PG8_WAIT_V(8); PG8_WAIT_L(0); PG8_BAR; PG8_MMA(1, 0, At, B0); PG8_MMA(1, 1, At, B1); PG8_BAR; PG8_SCHED;
            PG8_LDB(B0, 1, 0); PG8_LDB(B1, 1, 1); PG8_SCHED; PG8_LDA(At, 1, 0); PG8_STAGE(PG8_SA(0, 1), a2 + hstep, voffA);
            PG8_WAIT_V(8); PG8_WAIT_L(0); PG8_BAR; PG8_MMA(0, 0, At, B0); PG8_MMA(0, 1, At, B1); PG8_BAR; PG8_SCHED;
            PG8_LDA(At, 1, 1); PG8_STAGE(PG8_SB(1, 0), b3, voffB); PG8_STAGE(PG8_SB(1, 1), b3 + hstep, voffB); PG8_STAGE(PG8_SA(1, 0), a3, voffA);
            PG8_WAIT_V(8); PG8_WAIT_L(0); PG8_BAR; PG8_MMA(1, 0, At, B0); PG8_MMA(1, 1, At, B1); PG8_BAR; PG8_SCHED;
            } else {
            PG8_LDB(B0, 0, 0); PG8_SCHED; PG8_LDA(At, 0, 0); PG8_STAGE(PG8_SA(1, 1), a1 + hstep, voffA);
            PG8_WAIT_L(8); PG8_BAR; PG8_WAIT_L(0); PG8_MMA(0, 0, At, B0); PG8_BAR; PG8_SCHED;
            PG8_LDB(B1, 0, 1); PG8_STAGE(PG8_SB(0, 0), b2, voffB);
            PG8_BAR; PG8_WAIT_L(0); PG8_MMA(0, 1, At, B1); PG8_BAR;
            PG8_LDA(At, 0, 1); PG8_STAGE(PG8_SA(0, 0), a2, voffA);
            PG8_BAR; PG8_WAIT_L(0); PG8_MMA(1, 0, At, B0); PG8_BAR; PG8_SCHED;
            PG8_STAGE(PG8_SB(0, 1), b2 + hstep, voffB);
            PG8_WAIT_V(6); PG8_BAR; PG8_MMA(1, 1, At, B1); PG8_BAR;
            PG8_LDB(B0, 1, 0); PG8_SCHED; PG8_LDA(At, 1, 0); PG8_STAGE(PG8_SA(0, 1), a2 + hstep, voffA);
            PG8_WAIT_L(8); PG8_BAR; PG8_WAIT_L(0); PG8_MMA(0, 0, At, B0); PG8_BAR; PG8_SCHED;
            PG8_LDB(B1, 1, 1); PG8_STAGE(PG8_SB(1, 0), b3, voffB);
            PG8_BAR; PG8_WAIT_L(0); PG8_MMA(0, 1, At, B1); PG8_BAR;
            PG8_LDA(At, 1, 1); PG8_STAGE(PG8_SA(1, 0), a3, voffA);
            PG8_BAR; PG8_WAIT_L(0); PG8_MMA(1, 0, At, B0); PG8_BAR; PG8_SCHED;
            PG8_STAGE(PG8_SB(1, 1), b3 + hstep, voffB);
            PG8_WAIT_V(6); PG8_BAR; PG8_MMA(1, 1, At, B1); PG8_BAR;
            }
        }
        if constexpr (ALIGN_EPI) { if (wr == 0) PG8_BAR; }
        if constexpr (!Epi::AFTER_DRAIN) { E(acc, cur, wr, wc, fr, fq); S.done(cur); }
        if (!has_next) break;
#pragma unroll
        for (int a = 0; a < 2; ++a)
#pragma unroll
            for (int b = 0; b < 2; ++b)
#pragma unroll
                for (int m = 0; m < 4; ++m)
#pragma unroll
                    for (int n = 0; n < 2; ++n) acc[a][b][m][n] = (f32x4){0.f, 0.f, 0.f, 0.f};
        cur = nxt; cA = nA; cB = nB; ++ui;
        if constexpr (ALIGN_EPI) { if (wr == 1) PG8_BAR; }
    }
    PG8_WAIT_V(0);
    if constexpr (!ALIGN_EPI) { if (wr == 0) PG8_BAR; }
    PG8_BAR;
    if constexpr (Epi::AFTER_DRAIN) { E.fused(acc, cur, wr, wc, fr, fq, lds, wid, lane); S.done(cur); }
#undef PG8_SA
#undef PG8_SB
#undef PG8_STAGE
#undef PG8_LDA
#undef PG8_LDB
#undef PG8_MMA
#undef PG8_WAIT_V
#undef PG8_WAIT_L
#undef PG8_BAR
#undef PG8_SCHED
}
}

#define DI __device__ __forceinline__
#define LAS __attribute__((address_space(3)))
typedef unsigned short bf16;
typedef short bf16x8 __attribute__((ext_vector_type(8)));
typedef short s16x4 __attribute__((ext_vector_type(4)));
typedef float f32x4 __attribute__((ext_vector_type(4)));
typedef float f32x16 __attribute__((ext_vector_type(16)));
typedef unsigned u32x2 __attribute__((ext_vector_type(2)));
typedef unsigned u32x4 __attribute__((ext_vector_type(4)));

constexpr int NB = 16, SQ = 2048, DM = 1024, MROWS = NB * SQ, FF = 2816, NGU = 2 * FF, NIN = 2840, NINP = 3072;
constexpr float EPS = 1e-6f;
constexpr size_t MiB = 1u << 20;
constexpr size_t WS_CTL = 0, WS_ROPE = 1 * MiB, WS_CBIAS = 1 * MiB + 256 * 1024, WS_CW2 = 1 * MiB + 512 * 1024, WS_KC = 2 * MiB, WS_VCT = 2 * MiB + 512 * 1024,
                 WS_CW1 = 3 * MiB, WS_SSP = 5 * MiB, WS_GATES = 7 * MiB, WS_WOUT = 10 * MiB, WS_WIN = 12 * MiB, WS_WGU1 = 18 * MiB, WS_WD1 = 29 * MiB,
                 WS_WGU2 = 35 * MiB, WS_WD2 = 46 * MiB, WS_XN = 64 * MiB, WS_HD = 128 * MiB, WS_HB = 192 * MiB,
                 WS_DQ = 192 * MiB, WS_DK = 224 * MiB, WS_DVT = 256 * MiB, WS_NQ = 288 * MiB, WS_KV6 = 320 * MiB, WS_XR = 370 * MiB, WS_END = 436 * MiB;
constexpr size_t KVSLAB = (size_t)16 * 2 * 2048 * 64;
constexpr int LDS_BYTES = 131072 + 256;
constexpr size_t WS_BAR = 64 * 1024;
constexpr float SCL2 = 0.125f * 1.4426950408889634f;

#ifndef PG8_ALIGN_SW
#define PG8_ALIGN_SW true
#endif
struct Params { const float* in[26]; float* out; unsigned char* ws; };

DI float wave_sum(float v) {
#pragma unroll
    for (int o = 1; o < 64; o <<= 1) v += __shfl_xor(v, o);
    return v;
}
DI unsigned pk2(float lo, float hi) { return pg8::cvt_pk_bf16(lo, hi); }
DI float bf2f(unsigned short b) { return __builtin_bit_cast(float, (unsigned)b << 16); }
#define MFMA32(a, b, c) __builtin_amdgcn_mfma_f32_32x32x16_bf16((a), (b), (c), 0, 0, 0)
DI int crow(int i, int h) { return (i & 3) + 8 * (i >> 2) + 4 * h; }

#define XB_TMO      128
#define XB_XCNT(j)  (256  + 64 * (j))
#define XB_XSUB(j)  (1280 + 64 * (j))
#define XB_XGEN(j)  (2304 + 64 * (j))
#define XB_TOP      3328
#define XB_TOPGEN   3392
#define XCD_BAR_WORDS 3456
#define XB_SPIN_CAP (1u << 18)

__device__ __forceinline__ unsigned xb_ld(unsigned* p)              { return __hip_atomic_load(p, __ATOMIC_RELAXED, __HIP_MEMORY_SCOPE_AGENT); }
__device__ __forceinline__ unsigned xb_add(unsigned* p, unsigned v) { return __hip_atomic_fetch_add(p, v, __ATOMIC_RELAXED, __HIP_MEMORY_SCOPE_AGENT); }
__device__ __forceinline__ unsigned xb_xcc_id() { return (unsigned)__builtin_amdgcn_s_getreg((3 << 11) | 20) & 0xFu; }
#define XB_SPIN(cond, bar) do { unsigned _sp = 0; while (cond) { __builtin_amdgcn_s_sleep(1); \
    if ((++_sp & 255u) == 0u) { if (xb_ld(&(bar)[XB_TMO])) break; if (_sp > XB_SPIN_CAP) { atomicAdd(&(bar)[XB_TMO], 1u); break; } } } } while (0)

struct XcdBarrier {
    unsigned* bar; unsigned x;
    volatile LAS unsigned* st;
};

__device__ __forceinline__ XcdBarrier xcd_barrier_post(unsigned* bar, volatile LAS unsigned* st) {
    XcdBarrier b; b.bar = bar; b.x = xb_xcc_id(); b.st = st;
    if (threadIdx.x == 0) (void)xb_add(&bar[XB_XCNT(b.x)], 1u);
    return b;
}
__device__ __forceinline__ void xcd_barrier_complete(unsigned* bar, unsigned x, unsigned& nloc, unsigned& nx) {
    const unsigned G = gridDim.x * gridDim.y * gridDim.z;
    unsigned sum, cnt, mine, sp = 0u;
    for (;;) {
        sum = 0u; cnt = 0u; mine = 0u;
#pragma unroll
        for (unsigned j = 0; j < 16; ++j) { const unsigned c = xb_ld(&bar[XB_XCNT(j)]); sum += c; cnt += (c > 0u) ? 1u : 0u; mine = (j == x) ? c : mine; }
        if (sum == G) break;
        __builtin_amdgcn_s_sleep(1);
        if ((++sp & 255u) == 0u) { if (xb_ld(&bar[XB_TMO])) break; if (sp > XB_SPIN_CAP) { atomicAdd(&bar[XB_TMO], 1u); break; } }
    }
    nloc = mine > 0u ? mine : 1u; nx = cnt > 0u ? cnt : 1u;
}

__device__ __forceinline__ void xcd_barrier(const XcdBarrier& b) {
    asm volatile("s_waitcnt vmcnt(0)" ::: "memory");
    __syncthreads();
    if (threadIdx.x == 0) {
        unsigned* bar = b.bar;
        __builtin_amdgcn_s_waitcnt(0);
        unsigned nloc = b.st[0], nx = b.st[1];
        if (nloc == 0u) { xcd_barrier_complete(bar, b.x, nloc, nx); b.st[0] = nloc; b.st[1] = nx; }
        const unsigned old = xb_add(&bar[XB_XSUB(b.x)], 1u);
        const unsigned gen = old / nloc;
        if (old + 1u == (gen + 1u) * nloc) {
            __builtin_amdgcn_fence(__ATOMIC_RELEASE, "agent");
            asm volatile("s_waitcnt vmcnt(0)" ::: "memory");
            const unsigned og = xb_add(&bar[XB_TOP], 1u);
            const unsigned tg = og / nx;
            if (og + 1u == (tg + 1u) * nx) xb_add(&bar[XB_TOPGEN], 1u);
            else XB_SPIN(xb_ld(&bar[XB_TOPGEN]) == tg, bar);
            __builtin_amdgcn_fence(__ATOMIC_ACQUIRE, "agent");
            xb_add(&bar[XB_XGEN(b.x)], 1u);
            asm volatile("s_waitcnt vmcnt(0)" ::: "memory");
        } else {
            XB_SPIN(xb_ld(&bar[XB_XGEN(b.x)]) == gen, bar);
            __builtin_amdgcn_fence(__ATOMIC_ACQUIRE, "agent");
            asm volatile("s_waitcnt vmcnt(0)" ::: "memory");
        }
    }
    __syncthreads();
}

template <bool FRAG = false>
DI void transpose_item(const float* W, int K, int N, bf16* WT, int destrow0, LAS float* scr, int k0, int n0, int lane, const float* gk = nullptr) {
    const int col = n0 + (lane & 31);
#pragma unroll
    for (int i = 0; i < 32; ++i) { const int kk = 2 * i + (lane >> 5); const float gsc = gk ? gk[k0 + kk] : 1.f; scr[kk * 33 + (lane & 31)] = (col < N) ? __builtin_nontemporal_load(W + (size_t)(k0 + kk) * N + col) * gsc : 0.f; }
    asm volatile("s_waitcnt lgkmcnt(0)" ::: "memory");
    const int c = lane & 7;
#pragma unroll
    for (int j = 0; j < 4; ++j) { const int n = (lane >> 3) + 8 * j; const LAS float* s = scr + (8 * c) * 33 + n;
        u32x4 o; o.x = pk2(s[0 * 33], s[1 * 33]); o.y = pk2(s[2 * 33], s[3 * 33]); o.z = pk2(s[4 * 33], s[5 * 33]); o.w = pk2(s[6 * 33], s[7 * 33]);
        if (FRAG) {
            const int nn = destrow0 + n, kk = k0 + 8 * c;
            *(u32x4*)(WT + ((size_t)(((nn >> 5) * (K >> 4) + (kk >> 4)) * 64 + ((kk >> 3) & 1) * 32 + (nn & 31)) << 3)) = o;
        } else *(u32x4*)(WT + (size_t)(destrow0 + n) * K + k0 + 8 * c) = o; }
    asm volatile("s_waitcnt lgkmcnt(0)" ::: "memory");
}

template <bool HAS_H, int XIN, int XOUT, bool WRITE_XN>
DI void rows_phase(const void* xin_, const bf16* HD, const float* SSP, const float* gpost, float sc, void* xout_, const float* gpre, bf16* XN, float* RI, int gw, int NGW, int lane) {
    for (int m0 = gw; m0 < MROWS; m0 += 2 * NGW) {
        f32x4 v[2][4]; u32x2 hb[2][4]; f32x4 sp[2][4];
#pragma unroll
        for (int rr = 0; rr < 2; ++rr) {
            const int m = m0 + rr * NGW;
            if (XIN == 0) {
                const f32x4* xr = (const f32x4*)((const float*)xin_ + (size_t)m * DM) + lane;
#pragma unroll
                for (int j = 0; j < 4; ++j) v[rr][j] = __builtin_nontemporal_load(xr + 64 * j);
            } else {
                const u32x2* xr = (const u32x2*)((const bf16*)xin_ + (size_t)m * DM) + lane;
                const float ri = RI[m];
#pragma unroll
                for (int j = 0; j < 4; ++j) { const u32x2 w = __builtin_nontemporal_load(xr + 64 * j); v[rr][j][0] = ri * __builtin_bit_cast(float, w.x << 16); v[rr][j][1] = ri * __builtin_bit_cast(float, w.x & 0xffff0000u);
                    v[rr][j][2] = ri * __builtin_bit_cast(float, w.y << 16); v[rr][j][3] = ri * __builtin_bit_cast(float, w.y & 0xffff0000u); }
            }
            if (HAS_H) {
                const f32x4* spp = (const f32x4*)(SSP + (size_t)m * 16);
                const u32x2* hr = (const u32x2*)(HD + (size_t)m * DM) + lane;
#pragma unroll
                for (int j = 0; j < 4; ++j) { sp[rr][j] = spp[j]; hb[rr][j] = __builtin_nontemporal_load(hr + 64 * j); }
            }
        }
#pragma unroll
        for (int rr = 0; rr < 2; ++rr) {
            const int m = m0 + rr * NGW;
            if (HAS_H) {
                float ss = 0.f;
#pragma unroll
                for (int j = 0; j < 4; ++j) ss += (sp[rr][j][0] + sp[rr][j][1]) + (sp[rr][j][2] + sp[rr][j][3]);
                const float rh = sc * __builtin_amdgcn_rsqf(ss * (1.f / DM) + EPS);
#pragma unroll
                for (int j = 0; j < 4; ++j) {
                    const f32x4 g = ((const f32x4*)gpost)[lane + 64 * j];
                    v[rr][j][0] += bf2f((unsigned short)(hb[rr][j].x & 0xffffu)) * rh * g[0]; v[rr][j][1] += bf2f((unsigned short)(hb[rr][j].x >> 16)) * rh * g[1];
                    v[rr][j][2] += bf2f((unsigned short)(hb[rr][j].y & 0xffffu)) * rh * g[2]; v[rr][j][3] += bf2f((unsigned short)(hb[rr][j].y >> 16)) * rh * g[3];
                }
            }
            if (XOUT == 2) {
                f32x4* xo = (f32x4*)((float*)xout_ + (size_t)m * DM) + lane;
#pragma unroll
                for (int j = 0; j < 4; ++j) __builtin_nontemporal_store(v[rr][j], xo + 64 * j);
            }
            if (XOUT == 1) {
                u32x2* xo = (u32x2*)((bf16*)xout_ + (size_t)m * DM) + lane;
#pragma unroll
                for (int j = 0; j < 4; ++j) { u32x2 o; o.x = pk2(v[rr][j][0], v[rr][j][1]); o.y = pk2(v[rr][j][2], v[rr][j][3]); __builtin_nontemporal_store(o, xo + 64 * j);
                    v[rr][j][0] = __builtin_bit_cast(float, o.x << 16); v[rr][j][1] = __builtin_bit_cast(float, o.x & 0xffff0000u);
                    v[rr][j][2] = __builtin_bit_cast(float, o.y << 16); v[rr][j][3] = __builtin_bit_cast(float, o.y & 0xffff0000u); }
            }
            if (WRITE_XN) {
                float s2 = 0.f;
#pragma unroll
                for (int j = 0; j < 4; ++j) s2 += (v[rr][j][0] * v[rr][j][0] + v[rr][j][1] * v[rr][j][1]) + (v[rr][j][2] * v[rr][j][2] + v[rr][j][3] * v[rr][j][3]);
                const float ms = wave_sum(s2) * (1.f / DM) + EPS, rs = __builtin_amdgcn_rsqf(ms);
                if (lane == 0) RI[m] = ms * rs;
                u32x2* o8 = (u32x2*)(XN + (size_t)m * DM) + lane;
#pragma unroll
                for (int j = 0; j < 4; ++j) { u32x2 o; o.x = pk2(v[rr][j][0] * rs, v[rr][j][1] * rs); o.y = pk2(v[rr][j][2] * rs, v[rr][j][3] * rs); o8[64 * j] = o; }
            }
        }
    }
}

DI void compress_unit(int unit, const bf16* KV6, const bf16* CW1, const float* CBIAS, const bf16* CW2, bf16* KC, bf16* VCT, LAS unsigned char* lds, int wave, int lane, int tid) {
    const int kv = unit >> 7, bg = (unit >> 2) & 31, ct = unit & 3, r = lane & 31, h = lane >> 5;
    {
        const bf16* srcg = KV6 + (size_t)kv * KVSLAB + ((size_t)bg * 2048 + 512 * ct) * 64;
#pragma unroll
        for (int i = 0; i < 9; ++i) {
            const unsigned idx = (unsigned)tid + 512u * i;
            if (idx < 4224u) { const unsigned tk = idx >> 3, ch = idx & 7u; *(LAS u32x4*)(lds + tk * 128u + (tk >> 4) * 16u + ch * 16u) = *(const u32x4*)(srcg + idx * 8u); }
        }
    }
    __syncthreads();
    const bf16* w1 = CW1 + (size_t)kv * 256 * 2048 + ((size_t)wave * 128 * 64 + lane) * 8;
    f32x16 hacc;
#pragma unroll
    for (int i = 0; i < 16; ++i) hacc[i] = 0.f;
#pragma unroll 1
    for (int kb = 0; kb < 128; kb += 16) {
        bf16x8 a[16];
#pragma unroll
        for (int j = 0; j < 16; ++j) a[j] = *(const bf16x8*)(w1 + (size_t)(kb + j) * 512);
#pragma unroll
        for (int j = 0; j < 16; ++j) {
            const int ks = kb + j;
            const unsigned tk = 16u * r + (unsigned)(ks >> 2);
            const bf16x8 b = *(LAS const bf16x8*)(lds + tk * 128u + (tk >> 4) * 16u + (unsigned)(((ks & 3) * 16 + 8 * h) * 2));
            hacc = MFMA32(a[j], b, hacc);
        }
    }
    __syncthreads();
    const float* bias = CBIAS + kv * 256 + 32 * wave + 4 * h;
    float g[16];
#pragma unroll
    for (int a4 = 0; a4 < 4; ++a4) { const f32x4 bv = *(const f32x4*)(bias + 8 * a4);
#pragma unroll
        for (int e = 0; e < 4; ++e) { const float x = hacc[4 * a4 + e] + bv[e]; const float u2 = 2.f * 0.7978845608028654f * (x + 0.044715f * x * x * x);
            g[4 * a4 + e] = x * __builtin_amdgcn_rcpf(1.f + __builtin_amdgcn_exp2f(-1.4426950408889634f * u2)); } }
    f32x16 o2[2];
#pragma unroll
    for (int db = 0; db < 2; ++db)
#pragma unroll
        for (int i = 0; i < 16; ++i) o2[db][i] = 0.f;
    const bf16* w2 = CW2 + (size_t)kv * 64 * 256 + 32 * wave + 4 * h;
#pragma unroll
    for (int s = 0; s < 2; ++s) {
        u32x4 pb; pb.x = pk2(g[8 * s + 0], g[8 * s + 1]); pb.y = pk2(g[8 * s + 2], g[8 * s + 3]); pb.z = pk2(g[8 * s + 4], g[8 * s + 5]); pb.w = pk2(g[8 * s + 6], g[8 * s + 7]);
        const bf16x8 pbv = __builtin_bit_cast(bf16x8, pb);
#pragma unroll
        for (int db = 0; db < 2; ++db) {
            const bf16* wp = w2 + (size_t)(32 * db + r) * 256 + 16 * s;
            const s16x4 lo = *(const s16x4*)wp, hi = *(const s16x4*)(wp + 8);
            const bf16x8 af = __builtin_shufflevector(lo, hi, 0, 1, 2, 3, 4, 5, 6, 7);
            o2[db] = MFMA32(af, pbv, o2[db]);
        }
    }
    LAS float* red = (LAS float*)lds;
#pragma unroll
    for (int db = 0; db < 2; ++db)
#pragma unroll
        for (int i = 0; i < 16; ++i) red[(wave * 32 + db * 16 + i) * 64 + lane] = o2[db][i];
    __syncthreads();
    for (int e = tid; e < 2048; e += 512) {
        float s = 0.f;
#pragma unroll
        for (int w = 0; w < 8; ++w) s += red[w * 2048 + e];
        const int ln = e & 63, ri = e >> 6, db = ri >> 4, i = ri & 15, c = 32 * ct + (ln & 31), d = 32 * db + crow(i, ln >> 5);
        if (c == 127) s = 0.f;
        const unsigned short bv = pg8::cvt_bf16(s);
        if (kv == 0) KC[((size_t)bg * 128 + c) * 64 + d] = bv; else VCT[((size_t)bg * 64 + d) * 128 + c] = bv;
    }
    __syncthreads();
}

template <int MODE> DI bool key_valid(int key, int t, unsigned selmask) {
    if (MODE == 0) return key <= t;
    if (MODE == 1) return key <= t && key + 512 > t;
    if (MODE == 2) return key <= t && ((selmask >> (key >> 6)) & 1u);
    return key <= 126 && 16 * key + 31 <= t;
}
DI void load_q(bf16x8 (&qf)[4], const bf16* Qrow  ) {
#pragma unroll
    for (int ks = 0; ks < 4; ++ks) qf[ks] = *(const bf16x8*)(Qrow + 16 * ks);
}
DI f32x16 qk_tile(const bf16* Kt  , const bf16x8 (&qf)[4]) {
    f32x16 s;
#pragma unroll
    for (int i = 0; i < 16; ++i) s[i] = 0.f;
    bf16x8 kf[4];
#pragma unroll
    for (int ks = 0; ks < 4; ++ks) kf[ks] = *(const bf16x8*)(Kt + 16 * ks);
#pragma unroll
    for (int ks = 0; ks < 4; ++ks) s = MFMA32(kf[ks], qf[ks], s);
    return s;
}
template <int NDB, int MODE>
DI void attn_tile(const bf16* Kt, const bf16* Vt  , int ldv, const bf16x8 (&qf)[4], f32x16 (&o)[NDB], float& m, float& l, int key0, int t, int h, unsigned selmask) {
    f32x16 s = qk_tile(Kt, qf);
    __builtin_amdgcn_sched_barrier(0);
    float mx = -INFINITY;
#pragma unroll
    for (int i = 0; i < 16; ++i) { s[i] = key_valid<MODE>(key0 + crow(i, h), t, selmask) ? s[i] * SCL2 : -INFINITY; mx = fmaxf(mx, s[i]); }
    mx = fmaxf(mx, __shfl_xor(mx, 32));
    const float mn = fmaxf(m, mx), mu = (mn == -INFINITY) ? 0.f : mn;
    const float alpha = __builtin_amdgcn_exp2f(m - mu);
    float ps = 0.f;
#pragma unroll
    for (int i = 0; i < 16; ++i) { s[i] = __builtin_amdgcn_exp2f(s[i] - mu); ps += s[i]; }
    l = l * alpha + ps; m = mn;
#pragma unroll
    for (int db = 0; db < NDB; ++db)
#pragma unroll
        for (int i = 0; i < 16; ++i) o[db][i] *= alpha;
#pragma unroll
    for (int sI = 0; sI < 2; ++sI) {
        u32x4 pb; pb.x = pk2(s[8 * sI + 0], s[8 * sI + 1]); pb.y = pk2(s[8 * sI + 2], s[8 * sI + 3]); pb.z = pk2(s[8 * sI + 4], s[8 * sI + 5]); pb.w = pk2(s[8 * sI + 6], s[8 * sI + 7]);
        const bf16x8 pbv = __builtin_bit_cast(bf16x8, pb);
#pragma unroll
        for (int db = 0; db < NDB; ++db) {
            const bf16* vp = Vt + (size_t)(32 * db) * ldv + 16 * sI;
            const s16x4 lo = *(const s16x4*)vp, hi = *(const s16x4*)(vp + 8);
            const bf16x8 vf = __builtin_shufflevector(lo, hi, 0, 1, 2, 3, 4, 5, 6, 7);
            o[db] = MFMA32(vf, pbv, o[db]);
        }
    }
}
template <int NDB> DI void zero_o(f32x16 (&o)[NDB]) {
#pragma unroll
    for (int db = 0; db < NDB; ++db)
#pragma unroll
        for (int i = 0; i < 16; ++i) o[db][i] = 0.f;
}

DI void diff_unit(int b, int hh, int qt, float lam, const bf16* DQ, const bf16* DK, const bf16* DVT, const float* subln, bf16* AO, int lane) {
    const int r = lane & 31, h = lane >> 5, q0 = 32 * qt, t = q0 + r;
    f32x16 o0[4], o1[4];
    const bf16* Vb = DVT + (size_t)(b * 4 + hh) * 128 * 2048 + (size_t)r * 2048 + 4 * h;
#pragma unroll
    for (int mm = 0; mm < 2; ++mm) {
        const size_t slab = ((size_t)((b * 4 + hh) * 2 + mm) * 2048) * 64;
        bf16x8 qf[4]; load_q(qf, DQ + slab + (size_t)t * 64 + 8 * h);
        const bf16* Kb = DK + slab + (size_t)r * 64 + 8 * h;
        float m = -INFINITY, l = 0.f;
        zero_o<4>(o1);
        for (int kt = 0; kt <= qt; ++kt)
            attn_tile<4, 0>(Kb + (size_t)kt * 32 * 64, Vb + kt * 32, 2048, qf, o1, m, l, kt * 32, t, h, 0u);
        l += __shfl_xor(l, 32);
        const float inv = (l > 0.f) ? 1.f / l : 0.f;
        if (mm == 0) {
#pragma unroll
            for (int db = 0; db < 4; ++db)
#pragma unroll
                for (int i = 0; i < 16; ++i) o0[db][i] = o1[db][i] * inv;
        } else {
#pragma unroll
            for (int db = 0; db < 4; ++db)
#pragma unroll
                for (int i = 0; i < 16; ++i) o0[db][i] -= lam * inv * o1[db][i];
        }
    }
    float ss = 0.f;
#pragma unroll
    for (int db = 0; db < 4; ++db)
#pragma unroll
        for (int i = 0; i < 16; ++i) ss += o0[db][i] * o0[db][i];
    ss += __shfl_xor(ss, 32);
    const float rs = __builtin_amdgcn_rsqf(ss * (1.f / 128.f) + EPS) * 0.8f;
    bf16* orow = AO + (size_t)(b * 2048 + t) * 1024 + hh * 128 + 4 * h;
#pragma unroll
    for (int db = 0; db < 4; ++db)
#pragma unroll
        for (int a = 0; a < 4; ++a) {
            const f32x4 g = *(const f32x4*)(subln + 32 * db + 8 * a + 4 * h);
            u32x2 w; w.x = pk2(o0[db][4 * a + 0] * rs * g[0], o0[db][4 * a + 1] * rs * g[1]); w.y = pk2(o0[db][4 * a + 2] * rs * g[2], o0[db][4 * a + 3] * rs * g[3]);
            *(u32x2*)(orow + 32 * db + 8 * a) = w;
        }
}

DI void nsa_unit(int b, int g, int qt, const bf16* NQ, const bf16* KC, const bf16* VCT, const bf16* KV6, const float* GATES, bf16* AO, int lane) {
    const int r = lane & 31, h = lane >> 5, q0 = 32 * qt, t = q0 + r, bg = b * 2 + g;
    const bf16* KCb = KC + (size_t)bg * 128 * 64 + (size_t)r * 64 + 8 * h;
    const bf16* VCb = VCT + (size_t)bg * 64 * 128 + (size_t)r * 128 + 4 * h;
    const size_t kvoff = (size_t)bg * 2048 * 64;
    const bf16* KSb = KV6 + 2 * KVSLAB + kvoff + (size_t)r * 64 + 8 * h;
    const bf16* VSb = KV6 + 3 * KVSLAB + kvoff + (size_t)r * 2048 + 4 * h;
    const bf16* KWb = KV6 + 4 * KVSLAB + kvoff + (size_t)r * 64 + 8 * h;
    const bf16* VWb = KV6 + 5 * KVSLAB + kvoff + (size_t)r * 2048 + 4 * h;
    float imp[16];
#pragma unroll
    for (int i = 0; i < 16; ++i) imp[i] = 0.f;
#ifndef X_NOPASS1
#pragma unroll 1
    for (int hq = 0; hq < 4; ++hq) {
        bf16x8 qf[4]; load_q(qf, NQ + ((size_t)(b * 8 + g * 4 + hq) * 2048 + t) * 64 + 8 * h);
        f32x16 s[4]; float mx = -INFINITY;
#pragma unroll
        for (int T = 0; T < 4; ++T) {
            s[T] = qk_tile(KCb + (size_t)T * 32 * 64, qf);
            __builtin_amdgcn_sched_barrier(0);
#pragma unroll
            for (int i = 0; i < 16; ++i) { s[T][i] = key_valid<3>(32 * T + crow(i, h), t, 0u) ? s[T][i] : -INFINITY; mx = fmaxf(mx, s[T][i]); }
            __builtin_amdgcn_sched_barrier(0);
        }
        mx = fmaxf(mx, __shfl_xor(mx, 32));
        const float mu = (mx == -INFINITY) ? 0.f : mx;
        float ps = 0.f;
#pragma unroll
        for (int T = 0; T < 4; ++T)
#pragma unroll
            for (int i = 0; i < 16; ++i) { s[T][i] = __builtin_amdgcn_exp2f(s[T][i] - mu); ps += s[T][i]; }
        ps += __shfl_xor(ps, 32);
        const float inv = (ps > 0.f) ? 1.f / ps : 0.f;
        float xs[16];
#pragma unroll
        for (int idx = 0; idx < 16; ++idx) xs[idx] = __shfl_xor(s[idx >> 2][4 * (idx & 3) + 3], 32);
#pragma unroll
        for (int idx = 0; idx < 16; ++idx) {
            const int T = idx >> 2, a = idx & 3;
            const float w = s[T][4 * a] + s[T][4 * a + 1] + s[T][4 * a + 2] + 0.5f * s[T][4 * a + 3];
            const float cprev = (idx > 0) ? xs[idx > 0 ? idx - 1 : 0] : 0.f;
            const float carry = h ? xs[idx] : cprev;
            imp[idx] += (w + 0.5f * carry) * inv;
        }
    }
#endif
    unsigned selmask;
#ifdef X_NOTOPK
    selmask = (unsigned)imp[0];
#else
    {
        const int cur = t >> 6;
        float val[16], oth[16];
#pragma unroll
        for (int idx = 0; idx < 16; ++idx) { const int j = 2 * idx + h; const bool forced = (j == 0) || (j == cur) || (j == cur - 1);
            val[idx] = forced ? 1e9f : ((j <= cur) ? imp[idx] : -1.f); }
#pragma unroll
        for (int idx = 0; idx < 16; ++idx) oth[idx] = __shfl_xor(val[idx], 32);
        unsigned bits = 0u;
#pragma unroll
        for (int idx = 0; idx < 16; ++idx) {
            const int j = 2 * idx + h; const float v = val[idx]; int rank = 0;
#pragma unroll
            for (int i2 = 0; i2 < 16; ++i2) {
                const int j2 = 2 * i2 + h, j3 = 2 * i2 + 1 - h;
                rank += (val[i2] > v || (val[i2] == v && j2 < j)) ? 1 : 0;
                rank += (oth[i2] > v || (oth[i2] == v && j3 < j)) ? 1 : 0;
                asm volatile("" : "+v"(rank));
            }
            bits |= (rank < 16) ? (1u << j) : 0u;
        }
        selmask = bits | (unsigned)__shfl_xor((int)bits, 32);
    }
#endif
#pragma unroll 1
    for (int hq = 0; hq < 4; ++hq) {
        const int head = g * 4 + hq;
        bf16x8 qf[4]; load_q(qf, NQ + ((size_t)(b * 8 + head) * 2048 + t) * 64 + 8 * h);
        const float* gp = GATES + (size_t)(b * 2048 + t) * 24 + head * 3;
        const float g0 = gp[0], g1 = gp[1], g2 = gp[2];
        f32x16 out[2], o[2];
        zero_o<2>(out);
#ifndef X_NOCMP
        {
            float m = -INFINITY, l = 0.f; zero_o<2>(o);
#pragma unroll 1
            for (int T = 0; T < 4; ++T) attn_tile<2, 3>(KCb + (size_t)T * 32 * 64, VCb + T * 32, 128, qf, o, m, l, T * 32, t, h, 0u);
            l += __shfl_xor(l, 32); const float f = (l > 0.f) ? g0 / l : 0.f;
#pragma unroll
            for (int db = 0; db < 2; ++db)
#pragma unroll
                for (int i = 0; i < 16; ++i) out[db][i] += f * o[db][i];
        }
#endif
#ifndef X_NOSEL
        {
            float m = -INFINITY, l = 0.f; zero_o<2>(o);
#pragma unroll 1
            for (int kt = 0; kt <= qt; ++kt) {
                if (!__any((int)((selmask >> (kt >> 1)) & 1u))) continue;
                attn_tile<2, 2>(KSb + (size_t)kt * 32 * 64, VSb + kt * 32, 2048, qf, o, m, l, kt * 32, t, h, selmask);
            }
            l += __shfl_xor(l, 32); const float f = (l > 0.f) ? g1 / l : 0.f;
#pragma unroll
            for (int db = 0; db < 2; ++db)
#pragma unroll
                for (int i = 0; i < 16; ++i) out[db][i] += f * o[db][i];
        }
#endif
#ifndef X_NOWIN
        {
            float m = -INFINITY, l = 0.f; zero_o<2>(o);
            const int klo = (qt > 16) ? qt - 16 : 0;
#pragma unroll 1
            for (int kt = klo; kt <= qt; ++kt) attn_tile<2, 1>(KWb + (size_t)kt * 32 * 64, VWb + kt * 32, 2048, qf, o, m, l, kt * 32, t, h, 0u);
            l += __shfl_xor(l, 32); const float f = (l > 0.f) ? g2 / l : 0.f;
#pragma unroll
            for (int db = 0; db < 2; ++db)
#pragma unroll
                for (int i = 0; i < 16; ++i) out[db][i] += f * o[db][i];
        }
#endif
        bf16* orow = AO + (size_t)(b * 2048 + t) * 1024 + 512 + head * 64 + 4 * h;
#pragma unroll
        for (int db = 0; db < 2; ++db)
#pragma unroll
            for (int a = 0; a < 4; ++a) {
                u32x2 w; w.x = pk2(out[db][4 * a + 0], out[db][4 * a + 1]); w.y = pk2(out[db][4 * a + 2], out[db][4 * a + 3]);
                *(u32x2*)(orow + 32 * db + 8 * a) = w;
            }
    }
}


constexpr int KSTR = 72, VSTR = 68;
constexpr int KBUF_B = 64 * KSTR * 2, VBUF_B = 128 * VSTR * 2, ABUF_B = KBUF_B + VBUF_B;
constexpr int NBUF_B = KBUF_B + 64 * VSTR * 2;
constexpr int A_IMPX = 73728, A_MISC = A_IMPX + 8 * 16 * 64 * 4;
static_assert(4 * NBUF_B <= A_IMPX && 2 * ABUF_B <= A_IMPX && A_MISC + 256 <= 131072, "attention LDS map");
template <int NV> struct Stage { u32x4 k; u32x4 v[NV]; };
template <int NV> DI void stage_load(Stage<NV>& st, const bf16* Kg, const bf16* Vg, int ldv, int tid) {
    const unsigned ut = (unsigned)tid;
    st.k = *(const u32x4*)(Kg + ((ut >> 3) * 64u + (ut & 7u) * 8u));
#pragma unroll
    for (int i = 0; i < NV; ++i) { const unsigned idx = ut + 512u * i; st.v[i] = *(const u32x4*)(Vg + ((idx >> 3) * (unsigned)ldv + (idx & 7u) * 8u)); }
}
template <int NV> DI void stage_store(const Stage<NV>& st, LAS unsigned char* buf, int tid) {
    *(LAS u32x4*)(buf + ((tid >> 3) * KSTR + (tid & 7) * 8) * 2) = st.k;
#pragma unroll
    for (int i = 0; i < NV; ++i) { const int idx = tid + 512 * i; LAS unsigned char* q = buf + KBUF_B + ((idx >> 3) * VSTR + (idx & 7) * 8) * 2;
        u32x2 a; a.x = st.v[i].x; a.y = st.v[i].y; u32x2 b; b.x = st.v[i].z; b.y = st.v[i].w;
        *(LAS u32x2*)q = a; *(LAS u32x2*)(q + 8) = b; }
}
template <int NDB, int MODE, bool MASKED>
DI void tile_compute(LAS const unsigned char* buf, const bf16x8 (&qf)[4], f32x16 (&o)[NDB], float& m, float& l, int key0, int t, int r, int h, unsigned selmask) {
#pragma unroll
    for (int sub = 0; sub < 2; ++sub) {
        f32x16 s;
#pragma unroll
        for (int i = 0; i < 16; ++i) s[i] = 0.f;
        bf16x8 kf[4];
        LAS const unsigned char* kp = buf + ((sub * 32 + r) * KSTR + 8 * h) * 2;
#pragma unroll
        for (int ks = 0; ks < 4; ++ks) kf[ks] = *(LAS const bf16x8*)(kp + 32 * ks);
#pragma unroll
        for (int ks = 0; ks < 4; ++ks) s = MFMA32(kf[ks], qf[ks], s);
        __builtin_amdgcn_sched_barrier(0);
        float mx = -INFINITY;
        if (MASKED) {
#pragma unroll
            for (int i = 0; i < 16; ++i) { s[i] = key_valid<MODE>(key0 + 32 * sub + crow(i, h), t, selmask) ? s[i] : -INFINITY; mx = fmaxf(mx, s[i]); }
        } else {
#pragma unroll
            for (int i = 0; i < 16; ++i) mx = fmaxf(mx, s[i]);
        }
        mx = fmaxf(mx, __shfl_xor(mx, 32));
        const bool need = mx > m + 8.f;
        if (__any((int)need)) {
            const float mn = need ? mx : m;
            const float alpha = need ? __builtin_amdgcn_exp2f(m - mn) : 1.f;
            l *= alpha; m = mn;
#pragma unroll
            for (int db = 0; db < NDB; ++db)
#pragma unroll
                for (int i = 0; i < 16; ++i) o[db][i] *= alpha;
        }
        const float mu = (m == -INFINITY) ? 0.f : m;
        float ps = 0.f;
#pragma unroll
        for (int i = 0; i < 16; ++i) { s[i] = __builtin_amdgcn_exp2f(s[i] - mu); ps += s[i]; }
        l += ps;
#pragma unroll
        for (int sI = 0; sI < 2; ++sI) {
            u32x4 pb; pb.x = pk2(s[8 * sI + 0], s[8 * sI + 1]); pb.y = pk2(s[8 * sI + 2], s[8 * sI + 3]); pb.z = pk2(s[8 * sI + 4], s[8 * sI + 5]); pb.w = pk2(s[8 * sI + 6], s[8 * sI + 7]);
            const bf16x8 pbv = __builtin_bit_cast(bf16x8, pb);
#pragma unroll
            for (int db = 0; db < NDB; ++db) {
                LAS const unsigned char* vp = buf + KBUF_B + ((32 * db + r) * VSTR + 32 * sub + 16 * sI + 4 * h) * 2;
                const s16x4 lo = *(LAS const s16x4*)vp, hi = *(LAS const s16x4*)(vp + 16);
                const bf16x8 vf = __builtin_shufflevector(lo, hi, 0, 1, 2, 3, 4, 5, 6, 7);
                o[db] = MFMA32(vf, pbv, o[db]);
            }
        }
    }
}
template <int NDB, int MODE>
DI void flash_block(const bf16* Kg, const bf16* Vg, int ldv, unsigned tiles, LAS unsigned char* lds, const bf16x8 (&qf)[4], f32x16 (&o)[NDB], float& m, float& l,
                    int t, int qlo, int r, int h, unsigned selmask, int tid) {
    Stage<NDB / 2> st;
    unsigned rem = tiles; int cur = -1, bufi = 0;
    if (rem) { cur = __builtin_ctz(rem); rem &= rem - 1u; stage_load(st, Kg + (size_t)cur * 64 * 64, Vg + cur * 64, ldv, tid); }
    __syncthreads();
    while (cur >= 0) {
        LAS unsigned char* buf = lds + bufi * ABUF_B;
        stage_store(st, buf, tid);
        int nxt = -1;
        if (rem) { nxt = __builtin_ctz(rem); rem &= rem - 1u; stage_load(st, Kg + (size_t)nxt * 64 * 64, Vg + nxt * 64, ldv, tid); }
        __syncthreads();
        const int key0 = cur * 64;
        bool rel = true, msk = true;
        if (MODE == 0) { rel = key0 <= qlo + 31; msk = key0 + 63 > qlo; }
        if (MODE == 1) { rel = key0 <= qlo + 31 && key0 + 63 + 512 > qlo; msk = (key0 + 63 > qlo) || (key0 + 512 <= qlo + 31); }
        if (MODE == 2) { const int bit = (int)((selmask >> cur) & 1u); rel = key0 <= qlo + 31 && __any(bit); msk = (key0 + 63 > qlo) || !__all(bit); }
        if (rel) {
            if (msk) tile_compute<NDB, MODE, true>(buf, qf, o, m, l, key0, t, r, h, selmask);
            else tile_compute<NDB, MODE, false>(buf, qf, o, m, l, key0, t, r, h, selmask);
        }
        cur = nxt; bufi ^= 1;
    }
}

template <int MODE>
DI void flash_block2(const bf16* Kg, const bf16* Vg, int ldv, unsigned tiles, LAS unsigned char* lds, const bf16x8 (&qf)[4], f32x16 (&o)[2], float& m, float& l,
                     int t, int qlo, int r, int h, unsigned selmask, int tid) {
    Stage<1> st0, st1;
    unsigned rem = tiles; int c0 = -1, c1 = -1, bufi = 0;
    if (rem) { c0 = __builtin_ctz(rem); rem &= rem - 1u; stage_load(st0, Kg + (size_t)c0 * 64 * 64, Vg + c0 * 64, ldv, tid); }
    if (rem) { c1 = __builtin_ctz(rem); rem &= rem - 1u; stage_load(st1, Kg + (size_t)c1 * 64 * 64, Vg + c1 * 64, ldv, tid); }
    __syncthreads();
    while (c0 >= 0) {
        LAS unsigned char* bufa = lds + (2 * bufi) * NBUF_B;
        LAS unsigned char* bufb = bufa + NBUF_B;
        stage_store(st0, bufa, tid);
        if (c1 >= 0) stage_store(st1, bufb, tid);
        int n0 = -1, n1 = -1;
        if (rem) { n0 = __builtin_ctz(rem); rem &= rem - 1u; stage_load(st0, Kg + (size_t)n0 * 64 * 64, Vg + n0 * 64, ldv, tid); }
        if (rem) { n1 = __builtin_ctz(rem); rem &= rem - 1u; stage_load(st1, Kg + (size_t)n1 * 64 * 64, Vg + n1 * 64, ldv, tid); }
        __syncthreads();
#pragma unroll
        for (int half = 0; half < 2; ++half) {
            const int cur = half ? c1 : c0;
            if (cur < 0) continue;
            LAS unsigned char* buf = half ? bufb : bufa;
            const int key0 = cur * 64;
            bool rel = true, msk = true;
            if (MODE == 1) { rel = key0 <= qlo + 31 && key0 + 63 + 512 > qlo; msk = (key0 + 63 > qlo) || (key0 + 512 <= qlo + 31); }
            if (MODE == 2) { const int bit = (int)((selmask >> cur) & 1u); rel = key0 <= qlo + 31 && __any(bit); msk = (key0 + 63 > qlo) || !__all(bit); }
            if (rel) {
                if (msk) tile_compute<2, MODE, true>(buf, qf, o, m, l, key0, t, r, h, selmask);
                else tile_compute<2, MODE, false>(buf, qf, o, m, l, key0, t, r, h, selmask);
            }
        }
        c0 = n0; c1 = n1; bufi ^= 1;
    }
}

DI void diff_block(int b, int hh, int qb, float lam, const bf16* DQ, const bf16* DK, const bf16* DVT, const float* subln, bf16* AO, LAS unsigned char* lds, int wave, int lane, int tid) {
    const int r = lane & 31, h = lane >> 5, qlo = 256 * qb + 32 * wave, t = qlo + r;
    f32x16 o1[4];
    const bf16* Vg = DVT + (size_t)(b * 4 + hh) * 128 * 2048;
    const int ntile = 4 * qb + 4; const unsigned tiles = (ntile >= 32) ? 0xffffffffu : ((1u << ntile) - 1u);
    bf16* orow = AO + (size_t)(b * 2048 + t) * 1024 + hh * 128 + 4 * h;
    float ss = 0.f;
#pragma unroll 1
    for (int mm = 0; mm < 2; ++mm) {
        const size_t slab = ((size_t)((b * 4 + hh) * 2 + mm) * 2048) * 64;
        bf16x8 qf[4]; load_q(qf, DQ + slab + (size_t)t * 64 + 8 * h);
        float m = -INFINITY, l = 0.f;
        zero_o<4>(o1);
        flash_block<4, 0>(DK + slab, Vg, 2048, tiles, lds, qf, o1, m, l, t, qlo, r, h, 0u, tid);
        l += __shfl_xor(l, 32);
        const float inv = (l > 0.f) ? 1.f / l : 0.f;
        if (mm == 0) {
#pragma unroll
            for (int db = 0; db < 4; ++db)
#pragma unroll
                for (int a = 0; a < 4; ++a) {
                    u32x2 w; w.x = pk2(o1[db][4 * a + 0] * inv, o1[db][4 * a + 1] * inv); w.y = pk2(o1[db][4 * a + 2] * inv, o1[db][4 * a + 3] * inv);
                    *(u32x2*)(orow + 32 * db + 8 * a) = w;
                }
        } else {
            const float li = lam * inv;
#pragma unroll
            for (int db = 0; db < 4; ++db)
#pragma unroll
                for (int a = 0; a < 4; ++a) {
                    const u32x2 w = *(const u32x2*)(orow + 32 * db + 8 * a);
                    o1[db][4 * a + 0] = __builtin_bit_cast(float, w.x << 16) - li * o1[db][4 * a + 0];
                    o1[db][4 * a + 1] = __builtin_bit_cast(float, w.x & 0xffff0000u) - li * o1[db][4 * a + 1];
                    o1[db][4 * a + 2] = __builtin_bit_cast(float, w.y << 16) - li * o1[db][4 * a + 2];
                    o1[db][4 * a + 3] = __builtin_bit_cast(float, w.y & 0xffff0000u) - li * o1[db][4 * a + 3];
                    ss += (o1[db][4 * a + 0] * o1[db][4 * a + 0] + o1[db][4 * a + 1] * o1[db][4 * a + 1]) + (o1[db][4 * a + 2] * o1[db][4 * a + 2] + o1[db][4 * a + 3] * o1[db][4 * a + 3]);
                }
        }
    }
    ss += __shfl_xor(ss, 32);
    const float rs = __builtin_amdgcn_rsqf(ss * (1.f / 128.f) + EPS) * 0.8f;
#pragma unroll
    for (int db = 0; db < 4; ++db)
#pragma unroll
        for (int a = 0; a < 4; ++a) {
            const f32x4 g = *(const f32x4*)(subln + 32 * db + 8 * a + 4 * h);
            u32x2 w; w.x = pk2(o1[db][4 * a + 0] * rs * g[0], o1[db][4 * a + 1] * rs * g[1]); w.y = pk2(o1[db][4 * a + 2] * rs * g[2], o1[db][4 * a + 3] * rs * g[3]);
            *(u32x2*)(orow + 32 * db + 8 * a) = w;
        }
}

DI void nsa_block(int b, int g, int c, const bf16* NQ, const bf16* KC, const bf16* VCT, const bf16* KV6, const float* GATES, bf16* AO, LAS unsigned char* lds, int wave, int lane, int tid) {
    const int r = lane & 31, h = lane >> 5, hq = wave >> 1, qs = wave & 1, qlo = 64 * c + 32 * qs, t = qlo + r, bg = b * 2 + g, head = g * 4 + hq;
    const bf16* KCg = KC + (size_t)bg * 128 * 64;
    const bf16* VCg = VCT + (size_t)bg * 64 * 128;
    const size_t kvoff = (size_t)bg * 2048 * 64;
    bf16x8 qf[4]; load_q(qf, NQ + ((size_t)(b * 8 + head) * 2048 + t) * 64 + 8 * h);
    unsigned selmask, uni;
    const unsigned causal = (c >= 31) ? 0xffffffffu : ((2u << c) - 1u);
    if (c >= 16) {
    float imp[16];
    {
        const bf16* KCb = KCg + (size_t)r * 64 + 8 * h;
        f32x16 s[4]; float mx = -INFINITY;
#pragma unroll
        for (int T = 0; T < 4; ++T) {
            s[T] = qk_tile(KCb + (size_t)T * 32 * 64, qf);
            __builtin_amdgcn_sched_barrier(0);
#pragma unroll
            for (int i = 0; i < 16; ++i) { s[T][i] = key_valid<3>(32 * T + crow(i, h), t, 0u) ? s[T][i] : -INFINITY; mx = fmaxf(mx, s[T][i]); }
            __builtin_amdgcn_sched_barrier(0);
        }
        mx = fmaxf(mx, __shfl_xor(mx, 32));
        const float mu = (mx == -INFINITY) ? 0.f : mx;
        float ps = 0.f;
#pragma unroll
        for (int T = 0; T < 4; ++T)
#pragma unroll
            for (int i = 0; i < 16; ++i) { s[T][i] = __builtin_amdgcn_exp2f(s[T][i] - mu); ps += s[T][i]; }
        ps += __shfl_xor(ps, 32);
        const float inv = (ps > 0.f) ? 1.f / ps : 0.f;
        float xs[16];
#pragma unroll
        for (int idx = 0; idx < 16; ++idx) xs[idx] = __shfl_xor(s[idx >> 2][4 * (idx & 3) + 3], 32);
#pragma unroll
        for (int idx = 0; idx < 16; ++idx) {
            const int T = idx >> 2, a = idx & 3;
            const float w = s[T][4 * a] + s[T][4 * a + 1] + s[T][4 * a + 2] + 0.5f * s[T][4 * a + 3];
            const float cprev = (idx > 0) ? xs[idx > 0 ? idx - 1 : 0] : 0.f;
            const float carry = h ? xs[idx] : cprev;
            imp[idx] = (w + 0.5f * carry) * inv;
        }
    }
    LAS float* impx = (LAS float*)(lds + A_IMPX);
    LAS unsigned* misc = (LAS unsigned*)(lds + A_MISC);
#pragma unroll
    for (int idx = 0; idx < 16; ++idx) impx[(wave * 16 + idx) * 64 + lane] = imp[idx];
    if (tid == 0) misc[8] = 0u;
    __syncthreads();
#pragma unroll
    for (int idx = 0; idx < 16; ++idx) imp[idx] = (impx[((0 * 2 + qs) * 16 + idx) * 64 + lane] + impx[((1 * 2 + qs) * 16 + idx) * 64 + lane]) + (impx[((2 * 2 + qs) * 16 + idx) * 64 + lane] + impx[((3 * 2 + qs) * 16 + idx) * 64 + lane]);
    {
        const int cur = t >> 6;
        float val[16], oth[16];
#pragma unroll
        for (int idx = 0; idx < 16; ++idx) { const int j = 2 * idx + h; const bool forced = (j == 0) || (j == cur) || (j == cur - 1);
            val[idx] = forced ? 1e9f : ((j <= cur) ? imp[idx] : -1.f); }
#pragma unroll
        for (int idx = 0; idx < 16; ++idx) oth[idx] = __shfl_xor(val[idx], 32);
        unsigned bits = 0u;
#pragma unroll
        for (int idx = 0; idx < 16; ++idx) {
            const int j = 2 * idx + h; const float v = val[idx]; int rank = 0;
#pragma unroll
            for (int i2 = 0; i2 < 16; ++i2) {
                const int j2 = 2 * i2 + h, j3 = 2 * i2 + 1 - h;
                rank += (val[i2] > v || (val[i2] == v && j2 < j)) ? 1 : 0;
                rank += (oth[i2] > v || (oth[i2] == v && j3 < j)) ? 1 : 0;
                asm volatile("" : "+v"(rank));
            }
            bits |= (rank < 16) ? (1u << j) : 0u;
        }
        selmask = bits | (unsigned)__shfl_xor((int)bits, 32);
    }
    __hip_atomic_fetch_or((LAS unsigned*)&misc[8], selmask, __ATOMIC_RELAXED, __HIP_MEMORY_SCOPE_WORKGROUP);
    __syncthreads();
    uni = misc[8];
    uni = (unsigned)__builtin_amdgcn_readfirstlane((int)uni);
    } else { selmask = causal; uni = causal; }
    const float* gp = GATES + (size_t)(b * 2048 + t) * 24 + head * 3;
    const float g0 = gp[0], g1 = gp[1], g2 = gp[2];
    f32x16 out[2], o[2];
    zero_o<2>(out);
    {
        float m = -INFINITY, l = 0.f; zero_o<2>(o);
        flash_block2<3>(KCg, VCg, 128, 3u, lds, qf, o, m, l, t, qlo, r, h, 0u, tid);
        l += __shfl_xor(l, 32); const float f = (l > 0.f) ? g0 / l : 0.f;
#pragma unroll
        for (int db = 0; db < 2; ++db)
#pragma unroll
            for (int i = 0; i < 16; ++i) out[db][i] += f * o[db][i];
    }
    {
        float m = -INFINITY, l = 0.f; zero_o<2>(o);
        flash_block2<2>(KV6 + 2 * KVSLAB + kvoff, KV6 + 3 * KVSLAB + kvoff, 2048, uni & causal, lds, qf, o, m, l, t, qlo, r, h, selmask, tid);
        l += __shfl_xor(l, 32); const float f = (l > 0.f) ? g1 / l : 0.f;
#pragma unroll
        for (int db = 0; db < 2; ++db)
#pragma unroll
            for (int i = 0; i < 16; ++i) out[db][i] += f * o[db][i];
    }
    {
        float m = -INFINITY, l = 0.f; zero_o<2>(o);
        const unsigned lowm = (c > 8) ? ((1u << (c - 8)) - 1u) : 0u;
        flash_block2<1>(KV6 + 4 * KVSLAB + kvoff, KV6 + 5 * KVSLAB + kvoff, 2048, causal & ~lowm, lds, qf, o, m, l, t, qlo, r, h, 0u, tid);
        l += __shfl_xor(l, 32); const float f = (l > 0.f) ? g2 / l : 0.f;
#pragma unroll
        for (int db = 0; db < 2; ++db)
#pragma unroll
            for (int i = 0; i < 16; ++i) out[db][i] += f * o[db][i];
    }
    bf16* orow = AO + (size_t)(b * 2048 + t) * 1024 + 512 + head * 64 + 4 * h;
#pragma unroll
    for (int db = 0; db < 2; ++db)
#pragma unroll
        for (int a = 0; a < 4; ++a) {
            u32x2 w; w.x = pk2(out[db][4 * a + 0], out[db][4 * a + 1]); w.y = pk2(out[db][4 * a + 2], out[db][4 * a + 3]);
            *(u32x2*)(orow + 32 * db + 8 * a) = w;
        }
}

__global__ void __launch_bounds__(512) mega(Params p) {
    extern __shared__ __attribute__((aligned(16))) unsigned char lds_raw[];
    cg::grid_group grid = cg::this_grid();
    LAS unsigned char* lds = (LAS unsigned char*)lds_raw;
#define FRESH_IDS() int tid = threadIdx.x; asm volatile("" : "+v"(tid)); const int lane = tid & 63, wave = __builtin_amdgcn_readfirstlane(tid >> 6); const int gw = blockIdx.x * 8 + wave; (void)gw; (void)lane; (void)wave;
    const int G = gridDim.x, NGW = G * 8;
    unsigned char* ws = p.ws;
    unsigned* ctl = (unsigned*)(ws + WS_CTL);
    float* ROPE = (float*)(ws + WS_ROPE); float* CBIAS = (float*)(ws + WS_CBIAS); bf16* CW2 = (bf16*)(ws + WS_CW2); bf16* KC = (bf16*)(ws + WS_KC); bf16* VCT = (bf16*)(ws + WS_VCT);
    bf16* CW1 = (bf16*)(ws + WS_CW1); float* SSP = (float*)(ws + WS_SSP); float* GATES = (float*)(ws + WS_GATES);
    bf16* WOUT = (bf16*)(ws + WS_WOUT); bf16* WIN = (bf16*)(ws + WS_WIN); bf16* WGU1 = (bf16*)(ws + WS_WGU1); bf16* WD1 = (bf16*)(ws + WS_WD1); bf16* WGU2 = (bf16*)(ws + WS_WGU2); bf16* WD2 = (bf16*)(ws + WS_WD2);
    bf16* XR = (bf16*)(ws + WS_XR);
    float* RI = (float*)(ws + (52u << 20));
    bf16* XN = (bf16*)(ws + WS_XN); bf16* HD = (bf16*)(ws + WS_HD); bf16* HB = (bf16*)(ws + WS_HB);
    bf16* DQ = (bf16*)(ws + WS_DQ); bf16* DK = (bf16*)(ws + WS_DK); bf16* DVT = (bf16*)(ws + WS_DVT); bf16* NQ = (bf16*)(ws + WS_NQ); bf16* KV6 = (bf16*)(ws + WS_KV6);
    const float* x = p.in[0]; float* out = p.out;

    if (threadIdx.x < 64) ((LAS unsigned*)(lds + 131072))[threadIdx.x] = 0u;
    __syncthreads();
    XcdBarrier xbar = xcd_barrier_post((unsigned*)(ws + WS_BAR), (volatile LAS unsigned*)(lds + 131072));
#define GRID_SYNC() xcd_barrier(xbar)
    if (p.out == nullptr) grid.sync();
    {
        FRESH_IDS();
        if (blockIdx.x == 0 && tid < 64) ctl[tid] = 0u;
        LAS float* scr = (LAS float*)(lds + wave * 8448);
        constexpr int I_GU = 16 * 88, I_DN = 44 * 32, I_IN = 16 * 96, I_OUT = 16 * 32, I_C1 = 32 * 8, I_C2 = 4 * 2;
        constexpr int NITEMS = 4 * I_GU + 2 * I_DN + I_IN + I_OUT + 2 * I_C1 + 2 * I_C2;
        for (int it = gw; it < NITEMS; it += NGW) {
            int q = it;
            if (q < 4 * I_GU) {
                const int which = q / I_GU; q -= which * I_GU; const int kb = q / 88, nb = q % 88, n0 = 32 * nb;
                const float* W = p.in[which == 0 ? 2 : which == 1 ? 3 : which == 2 ? 22 : 23];
                bf16* dst = (which < 2) ? WGU1 : WGU2;
                transpose_item(W, 1024, FF, dst, 256 * (n0 >> 7) + (n0 & 127) + ((which & 1) ? 128 : 0), scr, 64 * kb, n0, lane, p.in[which < 2 ? 1 : 21]);
                continue;
            }
            q -= 4 * I_GU;
            if (q < 2 * I_DN) { const int which = q / I_DN; q -= which * I_DN; const int kb = q / 32, nb = q % 32;
                transpose_item(p.in[which ? 24 : 4], FF, 1024, which ? WD2 : WD1, 32 * nb, scr, 64 * kb, 32 * nb, lane); continue; }
            q -= 2 * I_DN;
            if (q < I_IN) { const int kb = q / 96, nb = q % 96; transpose_item(p.in[7], 1024, NIN, WIN, 32 * nb, scr, 64 * kb, 32 * nb, lane, p.in[6]); continue; }
            q -= I_IN;
            if (q < I_OUT) { const int kb = q / 32, nb = q % 32; transpose_item(p.in[19], 1024, 1024, WOUT, 32 * nb, scr, 64 * kb, 32 * nb, lane); continue; }
            q -= I_OUT;
            if (q < 2 * I_C1) { const int which = q / I_C1; q -= which * I_C1; const int kb = q / 8, nb = q % 8;
                transpose_item<true>(p.in[which ? 17 : 14], 2048, 256, CW1 + (size_t)which * 256 * 2048, 32 * nb, scr, 64 * kb, 32 * nb, lane); continue; }
            q -= 2 * I_C1;
            { const int which = q / I_C2; q -= which * I_C2; const int kb = q / 2, nb = q % 2;
              transpose_item(p.in[which ? 18 : 15], 256, 64, CW2 + (size_t)which * 64 * 256, 32 * nb, scr, 64 * kb, 32 * nb, lane); }
        }
        for (int i = blockIdx.x * 512 + tid; i < 2048 * 8; i += G * 512) {
            const int tt = i >> 3, e = i & 7;
            const double inv = exp2(-(double)e * (18.931568569324174 / 8.0));
            const double xr = (double)tt * inv * 0.15915494309189535;
            const double fr = xr - rint(xr);
            const float ang = (float)(fr * 6.283185307179586);
            ROPE[tt * 16 + e] = cosf(ang); ROPE[tt * 16 + 8 + e] = sinf(ang);
        }
        if ((int)blockIdx.x >= G - 16) {
            const int j = (G - 1) - (int)blockIdx.x, kv = j >> 3, sl = (j & 7) * 8 + wave;
            const float* pe = p.in[kv ? 16 : 13] + sl * 32; const float* w1 = p.in[kv ? 17 : 14] + (size_t)sl * 32 * 256;
            f32x4 a = {0.f, 0.f, 0.f, 0.f};
#pragma unroll
            for (int k = 0; k < 32; ++k) { const float pv = pe[k]; const f32x4 w = ((const f32x4*)(w1 + (size_t)k * 256))[lane]; a += pv * w; }
            ((f32x4*)(CBIAS + 1024 + (size_t)(kv * 64 + sl) * 256))[lane] = a;
        }
        rows_phase<false, 0, 0, true>(x, nullptr, nullptr, nullptr, 0.f, nullptr, nullptr, XN, RI, gw, NGW, lane);
    }
    GRID_SYNC();

#ifndef ONLY_ATT
#ifdef PROBE_SYNC
    for (int rep = 0; rep < 10; ++rep) GRID_SYNC();
#endif
#ifdef PROBE_P1
    for (int rep = 0; rep < 2; ++rep)
#endif
    { pg8::Gemm g{XN, WGU1, MROWS, NGU, DM}; pg8::StaticOrder S; S.init(MROWS, NGU, G, (int)blockIdx.x); pg8::EpiSwiglu E{HB, FF};
      pg8::gemm_phase<pg8::EpiSwiglu, pg8::StaticOrder, PG8_ALIGN_SW, true>(lds, g, S, E); }
    GRID_SYNC();
#ifdef PROBE_P2
    for (int rep = 0; rep < 2; ++rep)
#endif
    { pg8::Gemm g{HB, WD1, MROWS, DM, FF}; pg8::StaticOrder S; S.init(MROWS, DM, G, (int)blockIdx.x); pg8::EpiStoreSS E{HD, SSP};
      pg8::gemm_phase<pg8::EpiStoreSS, pg8::StaticOrder, true, true>(lds, g, S, E); }
    GRID_SYNC();
#ifdef PROBE_P3
    for (int rep = 0; rep < 2; ++rep)
#endif
    { FRESH_IDS();
      if (blockIdx.x == 0) { float s = 0.f; const float* pp = CBIAS + 1024 + (size_t)((tid >> 8) * 64) * 256 + (tid & 255);
#pragma unroll 16
          for (int q = 0; q < 64; ++q) s += pp[q * 256];
          CBIAS[tid] = s; }
      rows_phase<true, 1, 0, true>(XN, HD, SSP, p.in[5], 0.5f, nullptr, nullptr, XN, RI, gw, NGW, lane); }
    GRID_SYNC();
#ifdef PROBE_P4
    for (int rep = 0; rep < 2; ++rep)
#endif
    { pg8::Gemm g{XN, WIN, MROWS, NINP, DM}; pg8::StaticOrder S; S.init(MROWS, NINP, G, (int)blockIdx.x); pg8::EpiWin E{DQ, DK, DVT, NQ, KV6, GATES, ROPE};
      pg8::gemm_phase<pg8::EpiWin, pg8::StaticOrder, true, true>(lds, g, S, E); }
    GRID_SYNC();
#ifndef SKIP_CMP
#ifdef PROBE_P5
    for (int rep = 0; rep < 2; ++rep)
#endif
    { FRESH_IDS(); for (int u = blockIdx.x; u < 256; u += G) compress_unit(u, KV6, CW1, CBIAS, CW2, KC, VCT, lds, wave, lane, tid); }
#endif
    GRID_SYNC();
#endif
    {
        FRESH_IDS();
        float lam;
        { const float a = p.in[8][lane] * p.in[9][lane], c = p.in[10][lane] * p.in[11][lane];
          lam = __expf(wave_sum(a)) - __expf(wave_sum(c)) + 0.2f; }
        LAS unsigned* misc = (LAS unsigned*)(lds + A_MISC);
#ifdef PROBE_P6
        for (int rep = 0; rep < 2; ++rep)
#else
        const int rep = 0;
#endif
        {
#ifndef SKIP_DIFF
        for (;;) {
            __syncthreads();
            if (tid == 0) misc[0] = atomicAdd(ctl + 8 * rep, 1u);
            __syncthreads();
            const int u = __builtin_amdgcn_readfirstlane((int)misc[0]);
            if (u >= 512) break;
            int tidu = tid; asm volatile("" : "+v"(tidu));
            const int laneu = tidu & 63, waveu = __builtin_amdgcn_readfirstlane(tidu >> 6);
            const int idx = u & 63;
            diff_block(idx >> 2, idx & 3, 7 - (u >> 6), lam, DQ, DK, DVT, p.in[12], XR, lds, waveu, laneu, tidu);
        }
#endif
#ifndef SKIP_NSA
        for (;;) {
            __syncthreads();
            if (tid == 0) misc[0] = atomicAdd(ctl + 8 * rep + 4, 1u);
            __syncthreads();
            const int u = __builtin_amdgcn_readfirstlane((int)misc[0]);
            if (u >= 1024) break;
            int tidu = tid; asm volatile("" : "+v"(tidu));
            const int laneu = tidu & 63, waveu = __builtin_amdgcn_readfirstlane(tidu >> 6);
            const int idx = u & 31;
            nsa_block(idx >> 1, idx & 1, 31 - (u >> 5), NQ, KC, VCT, KV6, GATES, XR, lds, waveu, laneu, tidu);
        }
#endif
        }
    }
    GRID_SYNC();
#ifndef ONLY_ATT
    { pg8::Gemm g{XR, WOUT, MROWS, DM, DM}; pg8::StaticOrder S; S.init(MROWS, DM, G, (int)blockIdx.x); pg8::EpiStoreSS E{HD, SSP};
      pg8::gemm_phase<pg8::EpiStoreSS, pg8::StaticOrder, true, true>(lds, g, S, E); }
    GRID_SYNC();
    { FRESH_IDS(); rows_phase<true, 1, 0, true>(XN, HD, SSP, p.in[20], 1.0f, nullptr, nullptr, XN, RI, gw, NGW, lane); }
    GRID_SYNC();
    { pg8::Gemm g{XN, WGU2, MROWS, NGU, DM}; pg8::StaticOrder S; S.init(MROWS, NGU, G, (int)blockIdx.x); pg8::EpiSwiglu E{HB, FF};
      pg8::gemm_phase<pg8::EpiSwiglu, pg8::StaticOrder, PG8_ALIGN_SW, true>(lds, g, S, E); }
    GRID_SYNC();
    { pg8::Gemm g{HB, WD2, MROWS, DM, FF}; pg8::StaticOrder S; S.init(MROWS, DM, G, (int)blockIdx.x); pg8::EpiStoreSS E{HD, SSP};
      pg8::gemm_phase<pg8::EpiStoreSS, pg8::StaticOrder, true, true>(lds, g, S, E); }
    GRID_SYNC();
    { FRESH_IDS(); rows_phase<true, 1, 2, false>(XN, HD, SSP, p.in[25], 0.5f, out, nullptr, nullptr, RI, gw, NGW, lane); }
#endif
}

extern "C" void kernel_launch(void* const* d_in, const int* in_sizes, int n_in, void* d_out, int out_size, void* d_ws, size_t ws_size, hipStream_t stream) {
    static int grid_blocks = 0;
    if (!grid_blocks) {
        if (n_in != 26 || out_size != MROWS * DM || ws_size < WS_END) { fprintf(stderr, "kernel_launch: unexpected shapes n_in %d out %d ws %zu\n", n_in, out_size, ws_size); grid_blocks = -1; return; }
        int dev = 0, cus = 0, per_cu = 0;
        (void)hipGetDevice(&dev);
        (void)hipDeviceGetAttribute(&cus, hipDeviceAttributeMultiprocessorCount, dev);
        (void)hipFuncSetAttribute((const void*)mega, hipFuncAttributeMaxDynamicSharedMemorySize, LDS_BYTES);
        (void)hipOccupancyMaxActiveBlocksPerMultiprocessor(&per_cu, (const void*)mega, 512, LDS_BYTES);
        if (per_cu < 1) per_cu = 1;
        grid_blocks = cus * per_cu;
    }
    if (grid_blocks < 0) return;
    if (hipMemsetAsync((char*)d_ws + WS_BAR, 0, XCD_BAR_WORDS * sizeof(unsigned), stream) != hipSuccess) { fprintf(stderr, "kernel_launch: memset of the barrier words failed\n"); return; }
    Params p{};
    for (int i = 0; i < 26; ++i) p.in[i] = (const float*)d_in[i];
    p.out = (float*)d_out; p.ws = (unsigned char*)d_ws;
    void* args[] = {&p};
    hipError_t e = hipLaunchCooperativeKernel((void*)mega, dim3(grid_blocks), dim3(512), args, LDS_BYTES, stream);
    if (e != hipSuccess) fprintf(stderr, "cooperative launch failed: %s (grid %d)\n", hipGetErrorString(e), grid_blocks);
}
```

```cpp
#include <hip/hip_runtime.h>
#include <hip/hip_cooperative_groups.h>
#include <cstdio>
#include <cstdint>
namespace cg = cooperative_groups;
namespace pg8 {
#define PG8_LAS __attribute__((address_space(3)))
typedef unsigned short bf16_t;
typedef short bf16x8 __attribute__((ext_vector_type(8)));
typedef float f32x4 __attribute__((ext_vector_type(4)));
typedef unsigned u32x4 __attribute__((ext_vector_type(4)));
constexpr int BM = 256, BK = 64, HALF = 128, HTB = HALF * BK * 2  , STAGE_BYTES = 8 * HTB, NXCD = 8, WGM = 8;

__host__ __device__ __forceinline__ int lds_byte(int r, int c) { const int st = (r >> 4) * 2 + (c >> 5), rr = r & 15, cc = c & 31, ob = rr * 64 + cc * 2; return st * 1024 + (ob ^ (((ob >> 9) & 1) << 5)); }
__host__ __device__ __forceinline__ void stage_rc(int b, int& R, int& C) { const int st = b / 1024, sb = b % 1024, swz = sb ^ (((sb >> 9) & 1) << 5); R = (st >> 1) * 16 + swz / 64; C = (st & 1) * 32 + (swz % 64) / 2; }
__host__ __device__ __forceinline__ int perm32(int rho) { const int n = rho >> 4, i = rho & 15; return 8 * (i >> 2) + 4 * n + (i & 3); }

struct Unit { int pm, pn; };
struct Gemm { const bf16_t* A; const bf16_t* Bt; int M, N, K; };

struct StaticOrder {
    int nM, nN, nwg, G, c;
    __host__ __device__ void init(int M, int N, int G_, int c_) { nM = M / BM; nN = N / BM; nwg = nM * nN; G = G_; c = c_; }
    __host__ __device__ bool next(int i, Unit& u) const {
        const long L = (long)i * G + c; if (L >= nwg) return false;
        int wgid = (int)L; { const int q = nwg / NXCD, r = nwg % NXCD, xcd = wgid % NXCD, off = wgid / NXCD; wgid = (xcd < r ? xcd * (q + 1) : r * (q + 1) + (xcd - r) * q) + off; }
        const int nig = WGM * nN, gid = wgid / nig, fm = gid * WGM, gsz = (nM - fm) < WGM ? (nM - fm) : WGM;
        u.pm = fm + ((wgid % nig) % gsz); u.pn = (wgid % nig) / gsz; return true;
    }
    __device__ __forceinline__ void a_ready(const Unit&) const {}
    __device__ __forceinline__ void done(const Unit&) const {}
};


typedef float f32x2 __attribute__((ext_vector_type(2)));
typedef __bf16 bf16x2v __attribute__((ext_vector_type(2)));
__device__ __forceinline__ unsigned cvt_pk_bf16(float lo, float hi) { f32x2 v = {lo, hi}; bf16x2v b = __builtin_convertvector(v, bf16x2v); return __builtin_bit_cast(unsigned, b); }
__device__ __forceinline__ unsigned short cvt_bf16(float x) { return (unsigned short)(cvt_pk_bf16(x, 0.f) & 0xffffu); }
__device__ __forceinline__ float fast_sigmoid(float x) { return __builtin_amdgcn_rcpf(1.f + __builtin_amdgcn_exp2f(-1.4426950408889634f * x)); }
__device__ __forceinline__ void st8(bf16_t* p, const float* v) { u32x4 w; w.x = cvt_pk_bf16(v[0], v[1]); w.y = cvt_pk_bf16(v[2], v[3]); w.z = cvt_pk_bf16(v[4], v[5]); w.w = cvt_pk_bf16(v[6], v[7]); *(u32x4*)p = w; }

struct EpiSwiglu {
    static constexpr bool PERM = true, AFTER_DRAIN = false;
    bf16_t* O; int ldc;
    __device__ __forceinline__ void operator()(const f32x4 (&acc)[2][2][4][2], const Unit& u, int wr, int wc, int fr, int fq) const {
        const int row0 = u.pm * BM + wr * 64 + fr, col0 = u.pn * HALF + wc * 32 + 8 * fq;
#pragma unroll
        for (int ai = 0; ai < 2; ++ai)
#pragma unroll
            for (int m = 0; m < 4; ++m) {
                float v[8];
#pragma unroll
                for (int n = 0; n < 2; ++n)
#pragma unroll
                    for (int e = 0; e < 4; ++e) { const float g = acc[ai][0][m][n][e], up = acc[ai][1][m][n][e]; v[4 * n + e] = g * fast_sigmoid(g) * up; }
                { u32x4 w; w.x = cvt_pk_bf16(v[0], v[1]); w.y = cvt_pk_bf16(v[2], v[3]); w.z = cvt_pk_bf16(v[4], v[5]); w.w = cvt_pk_bf16(v[6], v[7]); __builtin_nontemporal_store(w, (u32x4*)(O + (size_t)(row0 + ai * HALF + m * 16) * ldc + col0)); }
            }
    }
};

struct EpiStoreSS {
    static constexpr bool PERM = true, AFTER_DRAIN = false;
    bf16_t* O; float* SSP;
    __device__ __forceinline__ void operator()(const f32x4 (&acc)[2][2][4][2], const Unit& u, int wr, int wc, int fr, int fq) const {
        const int row0 = u.pm * BM + wr * 64 + fr, col0 = u.pn * BM + wc * 32 + 8 * fq;
#pragma unroll
        for (int ai = 0; ai < 2; ++ai)
#pragma unroll
            for (int m = 0; m < 4; ++m) {
                const int row = row0 + ai * HALF + m * 16; float ss = 0.f;
#pragma unroll
                for (int bj = 0; bj < 2; ++bj) {
                    float v[8];
#pragma unroll
                    for (int n = 0; n < 2; ++n)
#pragma unroll
                        for (int e = 0; e < 4; ++e) { v[4 * n + e] = acc[ai][bj][m][n][e]; ss += v[4 * n + e] * v[4 * n + e]; }
                    st8(O + (size_t)row * 1024 + col0 + bj * HALF, v);
                }
                ss += __shfl_xor(ss, 16); ss += __shfl_xor(ss, 32);
                if (fq == 0) SSP[(size_t)row * 16 + u.pn * 4 + wc] = ss;
            }
    }
};

struct EpiWin {
    static constexpr bool PERM = true, AFTER_DRAIN = false;
    bf16_t *DQ, *DK, *DVT, *NQ, *KV6;
    float* GATES; const float* ROPE;
    __device__ __forceinline__ void operator()(const f32x4 (&acc)[2][2][4][2], const Unit& u, int wr, int wc, int fr, int fq) const {
        const int row0 = u.pm * BM + wr * 64 + fr;
#pragma unroll
        for (int bj = 0; bj < 2; ++bj) {
            const int cb = u.pn * BM + bj * HALF;
            const int col0 = cb + wc * 32 + 8 * fq;
            int kind; bf16_t* base = nullptr; int heads = 1, dshift = 6, c = 0;
            if (cb < 512)       { kind = 1; base = DQ;  c = col0; }
            else if (cb < 1024) { kind = 1; base = DK;  c = col0 - 512; }
            else if (cb < 1536) { kind = 2; base = DVT; c = col0 - 1024; heads = 4; dshift = 7; }
            else if (cb < 2048) { kind = 1; base = NQ;  c = col0 - 1536; }
            else if (cb < 2816) { const int idx = (cb - 2048) >> 7; base = KV6 + (size_t)idx * (16 * 2 * 2048 * 64); c = col0 - cb; heads = 2; dshift = 6;
                                  kind = (idx == 2 || idx == 4) ? 1 : ((idx == 3 || idx == 5) ? 2 : 0); }
            else if (cb == 2816) { kind = 3; c = col0 - 2816; }
            else { kind = 4; }
            if (kind == 4) continue;
            const float qsc = (cb < 512 || (cb >= 1536 && cb < 2048)) ? 0.18033688011112042f : 1.f;
            const int d0 = c & ((1 << dshift) - 1), hd = c >> dshift;
            int slabs = 8;
            if (cb >= 2048) slabs = 2;
#pragma unroll
            for (int ai = 0; ai < 2; ++ai)
#pragma unroll
                for (int m = 0; m < 4; ++m) {
                    const int row = row0 + ai * HALF + m * 16, b = row >> 11, t = row & 2047;
                    float v[8];
#pragma unroll
                    for (int n = 0; n < 2; ++n)
#pragma unroll
                        for (int e = 0; e < 4; ++e) v[4 * n + e] = acc[ai][bj][m][n][e] * qsc;
                    if (kind == 1) {
                        float pv[8];
#pragma unroll
                        for (int e = 0; e < 8; ++e) pv[e] = __shfl_xor(v[e], 16);
                        if (d0 < 16) {
                            const f32x4* cs = (const f32x4*)(ROPE + t * 16);
                            const f32x4 c0 = cs[0], c1 = cs[1], s0 = cs[2], s1 = cs[3];
                            const float sg = (d0 == 0) ? -1.f : 1.f;
#pragma unroll
                            for (int e = 0; e < 4; ++e) { v[e] = v[e] * c0[e] + sg * pv[e] * s0[e]; v[4 + e] = v[4 + e] * c1[e] + sg * pv[4 + e] * s1[e]; }
                        }
                    }
                    if (kind <= 1) {
                        st8(base + (((size_t)(b * slabs + hd) * 2048 + t) << 6) + d0, v);
                    } else if (kind == 2) {
                        bf16_t* p = base + ((size_t)((b * heads + hd) << dshift) + d0) * 2048 + t;
#pragma unroll
                        for (int e = 0; e < 8; ++e) p[(size_t)e * 2048] = cvt_bf16(v[e]);
                    } else {
                        if (c < 24) {
#pragma unroll
                            for (int e = 0; e < 8; ++e) GATES[(size_t)row * 24 + c + e] = fast_sigmoid(v[e]);
                        }
                    }
                }
        }
    }
};

template <class Epi, class Sched, bool ALIGN_EPI = false, bool SP2 = false>
__device__ __forceinline__ void gemm_phase(PG8_LAS unsigned char* lds, const Gemm g, const Sched& S, const Epi& E) {
    int tid_l = threadIdx.x; asm volatile("" : "+v"(tid_l));
    const int tid = tid_l, wid = __builtin_amdgcn_readfirstlane(tid >> 6), lane = tid & 63, wr = wid >> 2, wc = wid & 3, fr = lane & 15, fq = lane >> 4;
    const int K = g.K, nt = K / BK;
    unsigned voffA[2], voffB[2];
#pragma unroll
    for (int i = 0; i < 2; ++i) { int R, C; stage_rc(tid * 16 + i * 8192, R, C); const int Rb = Epi::PERM ? ((R & ~31) + perm32(R & 31)) : R;
        voffA[i] = (unsigned)(R * K + C) * 2u; voffB[i] = (unsigned)(Rb * K + C) * 2u; }
    const size_t kstep = (size_t)(BK * 2);
    const size_t hstep = (size_t)HALF * K * 2;
    const size_t tstep = 2 * hstep;
    const unsigned ldsw = (unsigned)wid * 1024u;
    const int aoff = lds_byte(wr * 64 + fr, fq * 8), boff = lds_byte(wc * 32 + fr, fq * 8);
#define PG8_SA(b, h) (((b) * 2 + (h)) * HTB)
#define PG8_SB(b, h) ((4 + (b) * 2 + (h)) * HTB)
#define PG8_STAGE(bufoff, gbase, voff) do { _Pragma("unroll") for (int _i = 0; _i < 2; ++_i) \
        __builtin_amdgcn_global_load_lds((const unsigned*)((const char*)(gbase) + (voff)[_i]), (PG8_LAS unsigned*)(lds + (bufoff) + ldsw + _i * 8192), 16, 0, 0); } while (0)
#define PG8_LDA(dst, b, h) do { _Pragma("unroll") for (int m = 0; m < 4; ++m) _Pragma("unroll") for (int k = 0; k < 2; ++k) dst[m][k] = *(const PG8_LAS bf16x8*)(lds + PG8_SA(b, h) + aoff + m * 2048 + k * 1024); } while (0)
#define PG8_LDB(dst, b, h) do { _Pragma("unroll") for (int n = 0; n < 2; ++n) _Pragma("unroll") for (int k = 0; k < 2; ++k) dst[n][k] = *(const PG8_LAS bf16x8*)(lds + PG8_SB(b, h) + boff + n * 2048 + k * 1024); } while (0)
#define PG8_MMA(ai, bj, At, Bt) do { __builtin_amdgcn_s_setprio(1); _Pragma("unroll") for (int m = 0; m < 4; ++m) _Pragma("unroll") for (int n = 0; n < 2; ++n) _Pragma("unroll") for (int k = 0; k < 2; ++k) \
        acc[ai][bj][m][n] = __builtin_amdgcn_mfma_f32_16x16x32_bf16(Bt[n][k], At[m][k], acc[ai][bj][m][n], 0, 0, 0); __builtin_amdgcn_s_setprio(0); } while (0)
#define PG8_WAIT_V(n) asm volatile("s_waitcnt vmcnt(" #n ")" ::: "memory")
#define PG8_WAIT_L(n) asm volatile("s_waitcnt lgkmcnt(" #n ")" ::: "memory")
#define PG8_BAR __builtin_amdgcn_s_barrier()
#define PG8_SCHED __builtin_amdgcn_sched_barrier(0)
    Unit cur, nxt; int ui = 0;
    if (!S.next(0, cur)) return;
    f32x4 acc[2][2][4][2];
#pragma unroll
    for (int a = 0; a < 2; ++a)
#pragma unroll
        for (int b = 0; b < 2; ++b)
#pragma unroll
            for (int m = 0; m < 4; ++m)
#pragma unroll
                for (int n = 0; n < 2; ++n) acc[a][b][m][n] = (f32x4){0.f, 0.f, 0.f, 0.f};
    bf16x8 At[4][2], B0[2][2], B1[2][2];
    const char* cA = (const char*)g.A + (size_t)cur.pm * tstep; const char* cB = (const char*)g.Bt + (size_t)cur.pn * tstep;
    S.a_ready(cur);
    if constexpr (SP2) {
        PG8_STAGE(PG8_SB(0, 0), cB, voffB); PG8_STAGE(PG8_SB(0, 1), cB + hstep, voffB); PG8_STAGE(PG8_SA(0, 0), cA, voffA); PG8_STAGE(PG8_SA(0, 1), cA + hstep, voffA);
        if (wr == 1) PG8_BAR;
        PG8_WAIT_V(2); PG8_BAR;
        PG8_STAGE(PG8_SB(1, 0), cB + kstep, voffB); PG8_STAGE(PG8_SA(1, 0), cA + kstep, voffA); PG8_STAGE(PG8_SB(1, 1), cB + hstep + kstep, voffB);
        PG8_WAIT_V(6); PG8_BAR;
    } else {
        PG8_STAGE(PG8_SB(0, 0), cB, voffB); PG8_STAGE(PG8_SA(0, 0), cA, voffA); PG8_STAGE(PG8_SB(0, 1), cB + hstep, voffB); PG8_STAGE(PG8_SA(0, 1), cA + hstep, voffA);
        if (wr == 1) PG8_BAR;
        PG8_WAIT_V(4); PG8_BAR;
        PG8_STAGE(PG8_SB(1, 0), cB + kstep, voffB); PG8_STAGE(PG8_SA(1, 0), cA + kstep, voffA); PG8_STAGE(PG8_SB(1, 1), cB + hstep + kstep, voffB);
        PG8_WAIT_V(6); PG8_BAR;
    }
    for (;;) {
        const bool has_next = S.next(ui + 1, nxt);
        const char* nA = has_next ? (const char*)g.A + (size_t)nxt.pm * tstep : cA; const char* nB = has_next ? (const char*)g.Bt + (size_t)nxt.pn * tstep : cB;
        for (int t = 0; t < nt; t += 2) {
            const bool last = (t == nt - 2);
            const char* a1 = cA + (size_t)(t + 1) * kstep;
            const char* a2 = last ? nA : cA + (size_t)(t + 2) * kstep; const char* b2 = last ? nB : cB + (size_t)(t + 2) * kstep;
            const char* a3 = a2 + kstep; const char* b3 = b2 + kstep;
            if (last && has_next) S.a_ready(nxt);
            if constexpr (SP2) {
            PG8_LDB(B0, 0, 0); PG8_LDB(B1, 0, 1); PG8_SCHED; PG8_LDA(At, 0, 0); PG8_STAGE(PG8_SA(1, 1), a1 + hstep, voffA);
            PG8_WAIT_V(8); PG8_WAIT_L(0); PG8_BAR; PG8_MMA(0, 0, At, B0); PG8_MMA(0, 1, At, B1); PG8_BAR; PG8_SCHED;
            PG8_LDA(At, 0, 1); PG8_STAGE(PG8_SB(0, 0), b2, voffB); PG8_STAGE(PG8_SB(0, 1), b2 + hstep, voffB); PG8_STAGE(PG8_SA(0, 0), a2, voffA);
            PG8_WAIT_V(8); PG8_WAIT_L(0); PG8_BAR; PG8_MMA(1, 0, At, B0); PG8_MMA(1, 1, At, B1); PG8_BAR; PG8_SCHED;
            PG8_LDB(B0, 1, 0); PG8_LDB(B1, 1, 1); PG8_SCHED; PG8_LDA(At, 1, 0); PG8_STAGE(PG8_SA(0, 1), a2 + hstep, voffA);
            PG8_WAIT_V(8); PG8_WAIT_L(0); PG8_BAR; PG8_MMA(0, 0, At, B0); PG8_MMA(0, 1, At, B1); PG8_BAR; PG8_SCHED;
            PG8_LDA(At, 1, 1); PG8_STAGE(PG8_SB(1, 0), b3, voffB); PG8_STAGE(PG8_SB(1, 1), b3 + hstep, voffB); PG8_STAGE(PG8_SA(1, 0), a3, voffA);
            PG8_WAIT_V(8); PG8_WAIT_L(0); PG8_BAR; PG8_MMA(1, 0, At, B0); PG8_MMA(1, 1, At, B1); PG8_BAR; PG8_SCHED;
            } else {
            PG8_LDB(B0, 0, 0); PG8_SCHED; PG8_LDA(At, 0, 0); PG8_STAGE(PG8_SA(1, 1), a1 + hstep, voffA);
            PG8_WAIT_L(8); PG8_BAR; PG8_WAIT_L(0); PG8_MMA(0, 0, At, B0); PG8_BAR; PG8_SCHED;
            PG8_LDB(B1, 0, 1); PG8_STAGE(PG8_SB(0, 0), b2, voffB);
            PG8_BAR; PG8_WAIT_L(0); PG8_MMA(0, 1, At, B1); PG8_BAR;
            PG8_LDA(At, 0, 1); PG8_STAGE(PG8_SA(0, 0), a2, voffA);
            PG8_BAR; PG8_WAIT_L(0); PG8_MMA(1, 0, At, B0); PG8_BAR; PG8_SCHED;
            PG8_STAGE(PG8_SB(0, 1), b2 + hstep, voffB);
            PG8_WAIT_V(6); PG8_BAR; PG8_MMA(1, 1, At, B1); PG8_BAR;
            PG8_LDB(B0, 1, 0); PG8_SCHED; PG8_LDA(At, 1, 0); PG8_STAGE(PG8_SA(0, 1), a2 + hstep, voffA);
            PG8_WAIT_L(8); PG8_BAR; PG8_WAIT_L(0); PG8_MMA(0, 0, At, B0); PG8_BAR; PG8_SCHED;
            PG8_LDB(B1, 1, 1); PG8_STAGE(PG8_SB(1, 0), b3, voffB);
            PG8_BAR; PG8_WAIT_L(0); PG8_MMA(0, 1, At, B1); PG8_BAR;
            PG8_LDA(At, 1, 1); PG8_STAGE(PG8_SA(1, 0), a3, voffA);
            PG8_BAR; PG8_WAIT_L(0); PG8_MMA(1, 0, At, B0); PG8_BAR; PG8_SCHED;
            PG8_STAGE(PG8_SB(1, 1), b3 + hstep, voffB);
            PG8_WAIT_V(6); PG8_BAR; PG8_MMA(1, 1, At, B1); PG8_BAR;
            }
        }
        if constexpr (ALIGN_EPI) { if (wr == 0) PG8_BAR; }
        if constexpr (!Epi::AFTER_DRAIN) { E(acc, cur, wr, wc, fr, fq); S.done(cur); }
        if (!has_next) break;
#pragma unroll
        for (int a = 0; a < 2; ++a)
#pragma unroll
            for (int b = 0; b < 2; ++b)
#pragma unroll
                for (int m = 0; m < 4; ++m)
#pragma unroll
                    for (int n = 0; n < 2; ++n) acc[a][b][m][n] = (f32x4){0.f, 0.f, 0.f, 0.f};
        cur = nxt; cA = nA; cB = nB; ++ui;
        if constexpr (ALIGN_EPI) { if (wr == 1) PG8_BAR; }
    }
    PG8_WAIT_V(0);
    if constexpr (!ALIGN_EPI) { if (wr == 0) PG8_BAR; }
    PG8_BAR;
    if constexpr (Epi::AFTER_DRAIN) { E.fused(acc, cur, wr, wc, fr, fq, lds, wid, lane); S.done(cur); }
#undef PG8_SA
#undef PG8_SB
#undef PG8_STAGE
#undef PG8_LDA
#undef PG8_LDB
#undef PG8_MMA
#undef PG8_WAIT_V
#undef PG8_WAIT_L
#undef PG8_BAR
#undef PG8_SCHED
}
}

#define DI __device__ __forceinline__
#define LAS __attribute__((address_space(3)))
typedef unsigned short bf16;
typedef short bf16x8 __attribute__((ext_vector_type(8)));
typedef short s16x4 __attribute__((ext_vector_type(4)));
typedef float f32x4 __attribute__((ext_vector_type(4)));
typedef float f32x16 __attribute__((ext_vector_type(16)));
typedef unsigned u32x2 __attribute__((ext_vector_type(2)));
typedef unsigned u32x4 __attribute__((ext_vector_type(4)));

constexpr int NB = 16, SQ = 2048, DM = 1024, MROWS = NB * SQ, FF = 2816, NGU = 2 * FF, NIN = 2840, NINP = 3072;
constexpr float EPS = 1e-6f;
constexpr size_t MiB = 1u << 20;
constexpr size_t WS_CTL = 0, WS_ROPE = 1 * MiB, WS_CBIAS = 1 * MiB + 256 * 1024, WS_CW2 = 1 * MiB + 512 * 1024, WS_KC = 2 * MiB, WS_VCT = 2 * MiB + 512 * 1024,
                 WS_CW1 = 3 * MiB, WS_SSP = 5 * MiB, WS_GATES = 7 * MiB, WS_WOUT = 10 * MiB, WS_WIN = 12 * MiB, WS_WGU1 = 18 * MiB, WS_WD1 = 29 * MiB,
                 WS_WGU2 = 35 * MiB, WS_WD2 = 46 * MiB, WS_XN = 64 * MiB, WS_HD = 128 * MiB, WS_HB = 192 * MiB,
                 WS_DQ = 192 * MiB, WS_DK = 224 * MiB, WS_DVT = 256 * MiB, WS_NQ = 288 * MiB, WS_KV6 = 320 * MiB, WS_XR = 370 * MiB, WS_END = 436 * MiB;
constexpr size_t KVSLAB = (size_t)16 * 2 * 2048 * 64;
constexpr int LDS_BYTES = 131072 + 256;
constexpr size_t WS_BAR = 64 * 1024;
constexpr float SCL2 = 0.125f * 1.4426950408889634f;

#ifndef PG8_ALIGN_SW
#define PG8_ALIGN_SW true
#endif
struct Params { const float* in[26]; float* out; unsigned char* ws; };

DI float wave_sum(float v) {
#pragma unroll
    for (int o = 1; o < 64; o <<= 1) v += __shfl_xor(v, o);
    return v;
}
DI unsigned pk2(float lo, float hi) { return pg8::cvt_pk_bf16(lo, hi); }
DI float bf2f(unsigned short b) { return __builtin_bit_cast(float, (unsigned)b << 16); }
#define MFMA32(a, b, c) __builtin_amdgcn_mfma_f32_32x32x16_bf16((a), (b), (c), 0, 0, 0)
DI int crow(int i, int h) { return (i & 3) + 8 * (i >> 2) + 4 * h; }

#define XB_TMO      128
#define XB_XCNT(j)  (256  + 64 * (j))
#define XB_XSUB(j)  (1280 + 64 * (j))
#define XB_XGEN(j)  (2304 + 64 * (j))
#define XB_TOP      3328
#define XB_TOPGEN   3392
#define XCD_BAR_WORDS 3456
#define XB_SPIN_CAP (1u << 18)

__device__ __forceinline__ unsigned xb_ld(unsigned* p)              { return __hip_atomic_load(p, __ATOMIC_RELAXED, __HIP_MEMORY_SCOPE_AGENT); }
__device__ __forceinline__ unsigned xb_add(unsigned* p, unsigned v) { return __hip_atomic_fetch_add(p, v, __ATOMIC_RELAXED, __HIP_MEMORY_SCOPE_AGENT); }
__device__ __forceinline__ unsigned xb_xcc_id() { return (unsigned)__builtin_amdgcn_s_getreg((3 << 11) | 20) & 0xFu; }
#define XB_SPIN(cond, bar) do { unsigned _sp = 0; while (cond) { __builtin_amdgcn_s_sleep(1); \
    if ((++_sp & 255u) == 0u) { if (xb_ld(&(bar)[XB_TMO])) break; if (_sp > XB_SPIN_CAP) { atomicAdd(&(bar)[XB_TMO], 1u); break; } } } } while (0)

struct XcdBarrier {
    unsigned* bar; unsigned x;
    volatile LAS unsigned* st;
};

__device__ __forceinline__ XcdBarrier xcd_barrier_post(unsigned* bar, volatile LAS unsigned* st) {
    XcdBarrier b; b.bar = bar; b.x = xb_xcc_id(); b.st = st;
    if (threadIdx.x == 0) (void)xb_add(&bar[XB_XCNT(b.x)], 1u);
    return b;
}
__device__ __forceinline__ void xcd_barrier_complete(unsigned* bar, unsigned x, unsigned& nloc, unsigned& nx) {
    const unsigned G = gridDim.x * gridDim.y * gridDim.z;
    unsigned sum, cnt, mine, sp = 0u;
    for (;;) {
        sum = 0u; cnt = 0u; mine = 0u;
#pragma unroll
        for (unsigned j = 0; j < 16; ++j) { const unsigned c = xb_ld(&bar[XB_XCNT(j)]); sum += c; cnt += (c > 0u) ? 1u : 0u; mine = (j == x) ? c : mine; }
        if (sum == G) break;
        __builtin_amdgcn_s_sleep(1);
        if ((++sp & 255u) == 0u) { if (xb_ld(&bar[XB_TMO])) break; if (sp > XB_SPIN_CAP) { atomicAdd(&bar[XB_TMO], 1u); break; } }
    }
    nloc = mine > 0u ? mine : 1u; nx = cnt > 0u ? cnt : 1u;
}

__device__ __forceinline__ void xcd_barrier(const XcdBarrier& b) {
    asm volatile("s_waitcnt vmcnt(0)" ::: "memory");
    __syncthreads();
    if (threadIdx.x == 0) {
        unsigned* bar = b.bar;
        __builtin_amdgcn_s_waitcnt(0);
        unsigned nloc = b.st[0], nx = b.st[1];
        if (nloc == 0u) { xcd_barrier_complete(bar, b.x, nloc, nx); b.st[0] = nloc; b.st[1] = nx; }
        const unsigned old = xb_add(&bar[XB_XSUB(b.x)], 1u);
        const unsigned gen = old / nloc;
        if (old + 1u == (gen + 1u) * nloc) {
            __builtin_amdgcn_fence(__ATOMIC_RELEASE, "agent");
            asm volatile("s_waitcnt vmcnt(0)" ::: "memory");
            const unsigned og = xb_add(&bar[XB_TOP], 1u);
            const unsigned tg = og / nx;
            if (og + 1u == (tg + 1u) * nx) xb_add(&bar[XB_TOPGEN], 1u);
            else XB_SPIN(xb_ld(&bar[XB_TOPGEN]) == tg, bar);
            __builtin_amdgcn_fence(__ATOMIC_ACQUIRE, "agent");
            xb_add(&bar[XB_XGEN(b.x)], 1u);
            asm volatile("s_waitcnt vmcnt(0)" ::: "memory");
        } else {
            XB_SPIN(xb_ld(&bar[XB_XGEN(b.x)]) == gen, bar);
            __builtin_amdgcn_fence(__ATOMIC_ACQUIRE, "agent");
            asm volatile("s_waitcnt vmcnt(0)" ::: "memory");
        }
    }
    __syncthreads();
}

template <bool FRAG = false>
DI void transpose_item(const float* W, int K, int N, bf16* WT, int destrow0, LAS float* scr, int k0, int n0, int lane, const float* gk = nullptr) {
    const int col = n0 + (lane & 31);
#pragma unroll
    for (int i = 0; i < 32; ++i) { const int kk = 2 * i + (lane >> 5); scr[kk * 33 + (lane & 31)] = (col < N) ? __builtin_nontemporal_load(W + (size_t)(k0 + kk) * N + col) : 0.f; }
    asm volatile("s_waitcnt lgkmcnt(0)" ::: "memory");
    const int c = lane & 7;
    f32x4 ga = {1.f, 1.f, 1.f, 1.f}, gb = ga;
    if (gk) { ga = *(const f32x4*)(gk + k0 + 8 * c); gb = *(const f32x4*)(gk + k0 + 8 * c + 4); }
#pragma unroll
    for (int j = 0; j < 4; ++j) { const int n = (lane >> 3) + 8 * j; const LAS float* s = scr + (8 * c) * 33 + n;
        u32x4 o; o.x = pk2(s[0 * 33] * ga[0], s[1 * 33] * ga[1]); o.y = pk2(s[2 * 33] * ga[2], s[3 * 33] * ga[3]); o.z = pk2(s[4 * 33] * gb[0], s[5 * 33] * gb[1]); o.w = pk2(s[6 * 33] * gb[2], s[7 * 33] * gb[3]);
        if (FRAG) {
            const int nn = destrow0 + n, kk = k0 + 8 * c;
            *(u32x4*)(WT + ((size_t)(((nn >> 5) * (K >> 4) + (kk >> 4)) * 64 + ((kk >> 3) & 1) * 32 + (nn & 31)) << 3)) = o;
        } else *(u32x4*)(WT + (size_t)(destrow0 + n) * K + k0 + 8 * c) = o; }
    asm volatile("s_waitcnt lgkmcnt(0)" ::: "memory");
}

template <bool HAS_H, int XIN, int XOUT, bool WRITE_XN>
DI void rows_phase(const void* xin_, const bf16* HD, const float* SSP, const float* gpost, float sc, void* xout_, const float* gpre, bf16* XN, float* RI, int gw, int NGW, int lane) {
    for (int m0 = gw; m0 < MROWS; m0 += 2 * NGW) {
        f32x4 v[2][4]; u32x2 hb[2][4]; f32x4 sp[2][4];
#pragma unroll
        for (int rr = 0; rr < 2; ++rr) {
            const int m = m0 + rr * NGW;
            if (XIN == 0) {
                const f32x4* xr = (const f32x4*)((const float*)xin_ + (size_t)m * DM) + lane;
#pragma unroll
                for (int j = 0; j < 4; ++j) v[rr][j] = __builtin_nontemporal_load(xr + 64 * j);
            } else {
                const u32x2* xr = (const u32x2*)((const bf16*)xin_ + (size_t)m * DM) + lane;
                const float ri = RI[m];
#pragma unroll
                for (int j = 0; j < 4; ++j) { const u32x2 w = __builtin_nontemporal_load(xr + 64 * j); v[rr][j][0] = ri * __builtin_bit_cast(float, w.x << 16); v[rr][j][1] = ri * __builtin_bit_cast(float, w.x & 0xffff0000u);
                    v[rr][j][2] = ri * __builtin_bit_cast(float, w.y << 16); v[rr][j][3] = ri * __builtin_bit_cast(float, w.y & 0xffff0000u); }
            }
            if (HAS_H) {
                const f32x4* spp = (const f32x4*)(SSP + (size_t)m * 16);
                const u32x2* hr = (const u32x2*)(HD + (size_t)m * DM) + lane;
#pragma unroll
                for (int j = 0; j < 4; ++j) { sp[rr][j] = spp[j]; hb[rr][j] = __builtin_nontemporal_load(hr + 64 * j); }
            }
        }
#pragma unroll
        for (int rr = 0; rr < 2; ++rr) {
            const int m = m0 + rr * NGW;
            if (HAS_H) {
                float ss = 0.f;
#pragma unroll
                for (int j = 0; j < 4; ++j) ss += (sp[rr][j][0] + sp[rr][j][1]) + (sp[rr][j][2] + sp[rr][j][3]);
                const float rh = sc * __builtin_amdgcn_rsqf(ss * (1.f / DM) + EPS);
#pragma unroll
                for (int j = 0; j < 4; ++j) {
                    const f32x4 g = ((const f32x4*)gpost)[lane + 64 * j];
                    v[rr][j][0] += bf2f((unsigned short)(hb[rr][j].x & 0xffffu)) * rh * g[0]; v[rr][j][1] += bf2f((unsigned short)(hb[rr][j].x >> 16)) * rh * g[1];
                    v[rr][j][2] += bf2f((unsigned short)(hb[rr][j].y & 0xffffu)) * rh * g[2]; v[rr][j][3] += bf2f((unsigned short)(hb[rr][j].y >> 16)) * rh * g[3];
                }
            }
            if (XOUT == 2) {
                f32x4* xo = (f32x4*)((float*)xout_ + (size_t)m * DM) + lane;
#pragma unroll
                for (int j = 0; j < 4; ++j) __builtin_nontemporal_store(v[rr][j], xo + 64 * j);
            }
            if (XOUT == 1) {
                u32x2* xo = (u32x2*)((bf16*)xout_ + (size_t)m * DM) + lane;
#pragma unroll
                for (int j = 0; j < 4; ++j) { u32x2 o; o.x = pk2(v[rr][j][0], v[rr][j][1]); o.y = pk2(v[rr][j][2], v[rr][j][3]); __builtin_nontemporal_store(o, xo + 64 * j);
                    v[rr][j][0] = __builtin_bit_cast(float, o.x << 16); v[rr][j][1] = __builtin_bit_cast(float, o.x & 0xffff0000u);
                    v[rr][j][2] = __builtin_bit_cast(float, o.y << 16); v[rr][j][3] = __builtin_bit_cast(float, o.y & 0xffff0000u); }
            }
            if (WRITE_XN) {
                float s2 = 0.f;
#pragma unroll
                for (int j = 0; j < 4; ++j) s2 += (v[rr][j][0] * v[rr][j][0] + v[rr][j][1] * v[rr][j][1]) + (v[rr][j][2] * v[rr][j][2] + v[rr][j][3] * v[rr][j][3]);
                const float ms = wave_sum(s2) * (1.f / DM) + EPS, rs = __builtin_amdgcn_rsqf(ms);
                if (lane == 0) RI[m] = ms * rs;
                u32x2* o8 = (u32x2*)(XN + (size_t)m * DM) + lane;
#pragma unroll
                for (int j = 0; j < 4; ++j) { u32x2 o; o.x = pk2(v[rr][j][0] * rs, v[rr][j][1] * rs); o.y = pk2(v[rr][j][2] * rs, v[rr][j][3] * rs); o8[64 * j] = o; }
            }
        }
    }
}

DI void compress_unit(int unit, const bf16* KV6, const bf16* CW1, const float* CBIAS, const bf16* CW2, bf16* KC, bf16* VCT, LAS unsigned char* lds, int wave, int lane, int tid) {
    const int kv = unit >> 7, bg = (unit >> 2) & 31, ct = unit & 3, r = lane & 31, h = lane >> 5;
    {
        const bf16* srcg = KV6 + (size_t)kv * KVSLAB + ((size_t)bg * 2048 + 512 * ct) * 64;
#pragma unroll
        for (int i = 0; i < 9; ++i) {
            const unsigned idx = (unsigned)tid + 512u * i;
            if (idx < 4224u) { const unsigned tk = idx >> 3, ch = idx & 7u; *(LAS u32x4*)(lds + tk * 128u + (tk >> 4) * 16u + ch * 16u) = *(const u32x4*)(srcg + idx * 8u); }
        }
    }
    __syncthreads();
    const bf16* w1 = CW1 + (size_t)kv * 256 * 2048 + ((size_t)wave * 128 * 64 + lane) * 8;
    f32x16 hacc;
#pragma unroll
    for (int i = 0; i < 16; ++i) hacc[i] = 0.f;
#pragma unroll 1
    for (int kb = 0; kb < 128; kb += 16) {
        bf16x8 a[16];
#pragma unroll
        for (int j = 0; j < 16; ++j) a[j] = *(const bf16x8*)(w1 + (size_t)(kb + j) * 512);
#pragma unroll
        for (int j = 0; j < 16; ++j) {
            const int ks = kb + j;
            const unsigned tk = 16u * r + (unsigned)(ks >> 2);
            const bf16x8 b = *(LAS const bf16x8*)(lds + tk * 128u + (tk >> 4) * 16u + (unsigned)(((ks & 3) * 16 + 8 * h) * 2));
            hacc = MFMA32(a[j], b, hacc);
        }
    }
    __syncthreads();
    const float* bias = CBIAS + kv * 256 + 32 * wave + 4 * h;
    float g[16];
#pragma unroll
    for (int a4 = 0; a4 < 4; ++a4) { const f32x4 bv = *(const f32x4*)(bias + 8 * a4);
#pragma unroll
        for (int e = 0; e < 4; ++e) { const float x = hacc[4 * a4 + e] + bv[e]; const float u2 = 2.f * 0.7978845608028654f * (x + 0.044715f * x * x * x);
            g[4 * a4 + e] = x * __builtin_amdgcn_rcpf(1.f + __builtin_amdgcn_exp2f(-1.4426950408889634f * u2)); } }
    f32x16 o2[2];
#pragma unroll
    for (int db = 0; db < 2; ++db)
#pragma unroll
        for (int i = 0; i < 16; ++i) o2[db][i] = 0.f;
    const bf16* w2 = CW2 + (size_t)kv * 64 * 256 + 32 * wave + 4 * h;
#pragma unroll
    for (int s = 0; s < 2; ++s) {
        u32x4 pb; pb.x = pk2(g[8 * s + 0], g[8 * s + 1]); pb.y = pk2(g[8 * s + 2], g[8 * s + 3]); pb.z = pk2(g[8 * s + 4], g[8 * s + 5]); pb.w = pk2(g[8 * s + 6], g[8 * s + 7]);
        const bf16x8 pbv = __builtin_bit_cast(bf16x8, pb);
#pragma unroll
        for (int db = 0; db < 2; ++db) {
            const bf16* wp = w2 + (size_t)(32 * db + r) * 256 + 16 * s;
            const s16x4 lo = *(const s16x4*)wp, hi = *(const s16x4*)(wp + 8);
            const bf16x8 af = __builtin_shufflevector(lo, hi, 0, 1, 2, 3, 4, 5, 6, 7);
            o2[db] = MFMA32(af, pbv, o2[db]);
        }
    }
    LAS float* red = (LAS float*)lds;
#pragma unroll
    for (int db = 0; db < 2; ++db)
#pragma unroll
        for (int i = 0; i < 16; ++i) red[(wave * 32 + db * 16 + i) * 64 + lane] = o2[db][i];
    __syncthreads();
    for (int e = tid; e < 2048; e += 512) {
        float s = 0.f;
#pragma unroll
        for (int w = 0; w < 8; ++w) s += red[w * 2048 + e];
        const int ln = e & 63, ri = e >> 6, db = ri >> 4, i = ri & 15, c = 32 * ct + (ln & 31), d = 32 * db + crow(i, ln >> 5);
        if (c == 127) s = 0.f;
        const unsigned short bv = pg8::cvt_bf16(s);
        if (kv == 0) KC[((size_t)bg * 128 + c) * 64 + d] = bv; else VCT[((size_t)bg * 64 + d) * 128 + c] = bv;
    }
    __syncthreads();
}

template <int MODE> DI bool key_valid(int key, int t, unsigned selmask) {
    if (MODE == 0) return key <= t;
    if (MODE == 1) return key <= t && key + 512 > t;
    if (MODE == 2) return key <= t && ((selmask >> (key >> 6)) & 1u);
    return key <= 126 && 16 * key + 31 <= t;
}
DI void load_q(bf16x8 (&qf)[4], const bf16* Qrow  ) {
#pragma unroll
    for (int ks = 0; ks < 4; ++ks) qf[ks] = *(const bf16x8*)(Qrow + 16 * ks);
}
DI f32x16 qk_tile(const bf16* Kt  , const bf16x8 (&qf)[4]) {
    f32x16 s;
#pragma unroll
    for (int i = 0; i < 16; ++i) s[i] = 0.f;
    bf16x8 kf[4];
#pragma unroll
    for (int ks = 0; ks < 4; ++ks) kf[ks] = *(const bf16x8*)(Kt + 16 * ks);
#pragma unroll
    for (int ks = 0; ks < 4; ++ks) s = MFMA32(kf[ks], qf[ks], s);
    return s;
}
template <int NDB, int MODE>
DI void attn_tile(const bf16* Kt, const bf16* Vt  , int ldv, const bf16x8 (&qf)[4], f32x16 (&o)[NDB], float& m, float& l, int key0, int t, int h, unsigned selmask) {
    f32x16 s = qk_tile(Kt, qf);
    __builtin_amdgcn_sched_barrier(0);
    float mx = -INFINITY;
#pragma unroll
    for (int i = 0; i < 16; ++i) { s[i] = key_valid<MODE>(key0 + crow(i, h), t, selmask) ? s[i] * SCL2 : -INFINITY; mx = fmaxf(mx, s[i]); }
    mx = fmaxf(mx, __shfl_xor(mx, 32));
    const float mn = fmaxf(m, mx), mu = (mn == -INFINITY) ? 0.f : mn;
    const float alpha = __builtin_amdgcn_exp2f(m - mu);
    float ps = 0.f;
#pragma unroll
    for (int i = 0; i < 16; ++i) { s[i] = __builtin_amdgcn_exp2f(s[i] - mu); ps += s[i]; }
    l = l * alpha + ps; m = mn;
#pragma unroll
    for (int db = 0; db < NDB; ++db)
#pragma unroll
        for (int i = 0; i < 16; ++i) o[db][i] *= alpha;
#pragma unroll
    for (int sI = 0; sI < 2; ++sI) {
        u32x4 pb; pb.x = pk2(s[8 * sI + 0], s[8 * sI + 1]); pb.y = pk2(s[8 * sI + 2], s[8 * sI + 3]); pb.z = pk2(s[8 * sI + 4], s[8 * sI + 5]); pb.w = pk2(s[8 * sI + 6], s[8 * sI + 7]);
        const bf16x8 pbv = __builtin_bit_cast(bf16x8, pb);
#pragma unroll
        for (int db = 0; db < NDB; ++db) {
            const bf16* vp = Vt + (size_t)(32 * db) * ldv + 16 * sI;
            const s16x4 lo = *(const s16x4*)vp, hi = *(const s16x4*)(vp + 8);
            const bf16x8 vf = __builtin_shufflevector(lo, hi, 0, 1, 2, 3, 4, 5, 6, 7);
            o[db] = MFMA32(vf, pbv, o[db]);
        }
    }
}
template <int NDB> DI void zero_o(f32x16 (&o)[NDB]) {
#pragma unroll
    for (int db = 0; db < NDB; ++db)
#pragma unroll
        for (int i = 0; i < 16; ++i) o[db][i] = 0.f;
}

DI void diff_unit(int b, int hh, int qt, float lam, const bf16* DQ, const bf16* DK, const bf16* DVT, const float* subln, bf16* AO, int lane) {
    const int r = lane & 31, h = lane >> 5, q0 = 32 * qt, t = q0 + r;
    f32x16 o0[4], o1[4];
    const bf16* Vb = DVT + (size_t)(b * 4 + hh) * 128 * 2048 + (size_t)r * 2048 + 4 * h;
#pragma unroll
    for (int mm = 0; mm < 2; ++mm) {
        const size_t slab = ((size_t)((b * 4 + hh) * 2 + mm) * 2048) * 64;
        bf16x8 qf[4]; load_q(qf, DQ + slab + (size_t)t * 64 + 8 * h);
        const bf16* Kb = DK + slab + (size_t)r * 64 + 8 * h;
        float m = -INFINITY, l = 0.f;
        zero_o<4>(o1);
        for (int kt = 0; kt <= qt; ++kt)
            attn_tile<4, 0>(Kb + (size_t)kt * 32 * 64, Vb + kt * 32, 2048, qf, o1, m, l, kt * 32, t, h, 0u);
        l += __shfl_xor(l, 32);
        const float inv = (l > 0.f) ? 1.f / l : 0.f;
        if (mm == 0) {
#pragma unroll
            for (int db = 0; db < 4; ++db)
#pragma unroll
                for (int i = 0; i < 16; ++i) o0[db][i] = o1[db][i] * inv;
        } else {
#pragma unroll
            for (int db = 0; db < 4; ++db)
#pragma unroll
                for (int i = 0; i < 16; ++i) o0[db][i] -= lam * inv * o1[db][i];
        }
    }
    float ss = 0.f;
#pragma unroll
    for (int db = 0; db < 4; ++db)
#pragma unroll
        for (int i = 0; i < 16; ++i) ss += o0[db][i] * o0[db][i];
    ss += __shfl_xor(ss, 32);
    const float rs = __builtin_amdgcn_rsqf(ss * (1.f / 128.f) + EPS) * 0.8f;
    bf16* orow = AO + (size_t)(b * 2048 + t) * 1024 + hh * 128 + 4 * h;
#pragma unroll
    for (int db = 0; db < 4; ++db)
#pragma unroll
        for (int a = 0; a < 4; ++a) {
            const f32x4 g = *(const f32x4*)(subln + 32 * db + 8 * a + 4 * h);
            u32x2 w; w.x = pk2(o0[db][4 * a + 0] * rs * g[0], o0[db][4 * a + 1] * rs * g[1]); w.y = pk2(o0[db][4 * a + 2] * rs * g[2], o0[db][4 * a + 3] * rs * g[3]);
            *(u32x2*)(orow + 32 * db + 8 * a) = w;
        }
}

DI void nsa_unit(int b, int g, int qt, const bf16* NQ, const bf16* KC, const bf16* VCT, const bf16* KV6, const float* GATES, bf16* AO, int lane) {
    const int r = lane & 31, h = lane >> 5, q0 = 32 * qt, t = q0 + r, bg = b * 2 + g;
    const bf16* KCb = KC + (size_t)bg * 128 * 64 + (size_t)r * 64 + 8 * h;
    const bf16* VCb = VCT + (size_t)bg * 64 * 128 + (size_t)r * 128 + 4 * h;
    const size_t kvoff = (size_t)bg * 2048 * 64;
    const bf16* KSb = KV6 + 2 * KVSLAB + kvoff + (size_t)r * 64 + 8 * h;
    const bf16* VSb = KV6 + 3 * KVSLAB + kvoff + (size_t)r * 2048 + 4 * h;
    const bf16* KWb = KV6 + 4 * KVSLAB + kvoff + (size_t)r * 64 + 8 * h;
    const bf16* VWb = KV6 + 5 * KVSLAB + kvoff + (size_t)r * 2048 + 4 * h;
    float imp[16];
#pragma unroll
    for (int i = 0; i < 16; ++i) imp[i] = 0.f;
#ifndef X_NOPASS1
#pragma unroll 1
    for (int hq = 0; hq < 4; ++hq) {
        bf16x8 qf[4]; load_q(qf, NQ + ((size_t)(b * 8 + g * 4 + hq) * 2048 + t) * 64 + 8 * h);
        f32x16 s[4]; float mx = -INFINITY;
#pragma unroll
        for (int T = 0; T < 4; ++T) {
            s[T] = qk_tile(KCb + (size_t)T * 32 * 64, qf);
            __builtin_amdgcn_sched_barrier(0);
#pragma unroll
            for (int i = 0; i < 16; ++i) { s[T][i] = key_valid<3>(32 * T + crow(i, h), t, 0u) ? s[T][i] : -INFINITY; mx = fmaxf(mx, s[T][i]); }
            __builtin_amdgcn_sched_barrier(0);
        }
        mx = fmaxf(mx, __shfl_xor(mx, 32));
        const float mu = (mx == -INFINITY) ? 0.f : mx;
        float ps = 0.f;
#pragma unroll
        for (int T = 0; T < 4; ++T)
#pragma unroll
            for (int i = 0; i < 16; ++i) { s[T][i] = __builtin_amdgcn_exp2f(s[T][i] - mu); ps += s[T][i]; }
        ps += __shfl_xor(ps, 32);
        const float inv = (ps > 0.f) ? 1.f / ps : 0.f;
        float xs[16];
#pragma unroll
        for (int idx = 0; idx < 16; ++idx) xs[idx] = __shfl_xor(s[idx >> 2][4 * (idx & 3) + 3], 32);
#pragma unroll
        for (int idx = 0; idx < 16; ++idx) {
            const int T = idx >> 2, a = idx & 3;
            const float w = s[T][4 * a] + s[T][4 * a + 1] + s[T][4 * a + 2] + 0.5f * s[T][4 * a + 3];
            const float cprev = (idx > 0) ? xs[idx > 0 ? idx - 1 : 0] : 0.f;
            const float carry = h ? xs[idx] : cprev;
            imp[idx] += (w + 0.5f * carry) * inv;
        }
    }
#endif
    unsigned selmask;
#ifdef X_NOTOPK
    selmask = (unsigned)imp[0];
#else
    {
        const int cur = t >> 6;
        float val[16], oth[16];
#pragma unroll
        for (int idx = 0; idx < 16; ++idx) { const int j = 2 * idx + h; const bool forced = (j == 0) || (j == cur) || (j == cur - 1);
            val[idx] = forced ? 1e9f : ((j <= cur) ? imp[idx] : -1.f); }
#pragma unroll
        for (int idx = 0; idx < 16; ++idx) oth[idx] = __shfl_xor(val[idx], 32);
        unsigned bits = 0u;
#pragma unroll
        for (int idx = 0; idx < 16; ++idx) {
            const int j = 2 * idx + h; const float v = val[idx]; int rank = 0;
#pragma unroll
            for (int i2 = 0; i2 < 16; ++i2) {
                const int j2 = 2 * i2 + h, j3 = 2 * i2 + 1 - h;
                rank += (val[i2] > v || (val[i2] == v && j2 < j)) ? 1 : 0;
                rank += (oth[i2] > v || (oth[i2] == v && j3 < j)) ? 1 : 0;
                asm volatile("" : "+v"(rank));
            }
            bits |= (rank < 16) ? (1u << j) : 0u;
        }
        selmask = bits | (unsigned)__shfl_xor((int)bits, 32);
    }
#endif
#pragma unroll 1
    for (int hq = 0; hq < 4; ++hq) {
        const int head = g * 4 + hq;
        bf16x8 qf[4]; load_q(qf, NQ + ((size_t)(b * 8 + head) * 2048 + t) * 64 + 8 * h);
        const float* gp = GATES + (size_t)(b * 2048 + t) * 24 + head * 3;
        const float g0 = gp[0], g1 = gp[1], g2 = gp[2];
        f32x16 out[2], o[2];
        zero_o<2>(out);
#ifndef X_NOCMP
        {
            float m = -INFINITY, l = 0.f; zero_o<2>(o);
#pragma unroll 1
            for (int T = 0; T < 4; ++T) attn_tile<2, 3>(KCb + (size_t)T * 32 * 64, VCb + T * 32, 128, qf, o, m, l, T * 32, t, h, 0u);
            l += __shfl_xor(l, 32); const float f = (l > 0.f) ? g0 / l : 0.f;
#pragma unroll
            for (int db = 0; db < 2; ++db)
#pragma unroll
                for (int i = 0; i < 16; ++i) out[db][i] += f * o[db][i];
        }
#endif
#ifndef X_NOSEL
        {
            float m = -INFINITY, l = 0.f; zero_o<2>(o);
#pragma unroll 1
            for (int kt = 0; kt <= qt; ++kt) {
                if (!__any((int)((selmask >> (kt >> 1)) & 1u))) continue;
                attn_tile<2, 2>(KSb + (size_t)kt * 32 * 64, VSb + kt * 32, 2048, qf, o, m, l, kt * 32, t, h, selmask);
            }
            l += __shfl_xor(l, 32); const float f = (l > 0.f) ? g1 / l : 0.f;
#pragma unroll
            for (int db = 0; db < 2; ++db)
#pragma unroll
                for (int i = 0; i < 16; ++i) out[db][i] += f * o[db][i];
        }
#endif
#ifndef X_NOWIN
        {
            float m = -INFINITY, l = 0.f; zero_o<2>(o);
            const int klo = (qt > 16) ? qt - 16 : 0;
#pragma unroll 1
            for (int kt = klo; kt <= qt; ++kt) attn_tile<2, 1>(KWb + (size_t)kt * 32 * 64, VWb + kt * 32, 2048, qf, o, m, l, kt * 32, t, h, 0u);
            l += __shfl_xor(l, 32); const float f = (l > 0.f) ? g2 / l : 0.f;
#pragma unroll
            for (int db = 0; db < 2; ++db)
#pragma unroll
                for (int i = 0; i < 16; ++i) out[db][i] += f * o[db][i];
        }
#endif
        bf16* orow = AO + (size_t)(b * 2048 + t) * 1024 + 512 + head * 64 + 4 * h;
#pragma unroll
        for (int db = 0; db < 2; ++db)
#pragma unroll
            for (int a = 0; a < 4; ++a) {
                u32x2 w; w.x = pk2(out[db][4 * a + 0], out[db][4 * a + 1]); w.y = pk2(out[db][4 * a + 2], out[db][4 * a + 3]);
                *(u32x2*)(orow + 32 * db + 8 * a) = w;
            }
    }
}


constexpr int KSTR = 72, VSTR = 68;
constexpr int KBUF_B = 64 * KSTR * 2, VBUF_B = 128 * VSTR * 2, ABUF_B = KBUF_B + VBUF_B;
constexpr int NBUF_B = KBUF_B + 64 * VSTR * 2;
constexpr int A_IMPX = 73728, A_MISC = A_IMPX + 8 * 16 * 64 * 4;
static_assert(4 * NBUF_B <= A_IMPX && 2 * ABUF_B <= A_IMPX && A_MISC + 256 <= 131072, "attention LDS map");
template <int NV> struct Stage { u32x4 k; u32x4 v[NV]; };
template <int NV> DI void stage_load(Stage<NV>& st, const bf16* Kg, const bf16* Vg, int ldv, int tid) {
    const unsigned ut = (unsigned)tid;
    st.k = *(const u32x4*)(Kg + ((ut >> 3) * 64u + (ut & 7u) * 8u));
#pragma unroll
    for (int i = 0; i < NV; ++i) { const unsigned idx = ut + 512u * i; st.v[i] = *(const u32x4*)(Vg + ((idx >> 3) * (unsigned)ldv + (idx & 7u) * 8u)); }
}
template <int NV> DI void stage_store(const Stage<NV>& st, LAS unsigned char* buf, int tid) {
    *(LAS u32x4*)(buf + ((tid >> 3) * KSTR + (tid & 7) * 8) * 2) = st.k;
#pragma unroll
    for (int i = 0; i < NV; ++i) { const int idx = tid + 512 * i; LAS unsigned char* q = buf + KBUF_B + ((idx >> 3) * VSTR + (idx & 7) * 8) * 2;
        u32x2 a; a.x = st.v[i].x; a.y = st.v[i].y; u32x2 b; b.x = st.v[i].z; b.y = st.v[i].w;
        *(LAS u32x2*)q = a; *(LAS u32x2*)(q + 8) = b; }
}
template <int NDB, int MODE, bool MASKED>
DI void tile_compute(LAS const unsigned char* buf, const bf16x8 (&qf)[4], f32x16 (&o)[NDB], float& m, float& l, int key0, int t, int r, int h, unsigned selmask) {
#pragma unroll
    for (int sub = 0; sub < 2; ++sub) {
        f32x16 s;
#pragma unroll
        for (int i = 0; i < 16; ++i) s[i] = 0.f;
        bf16x8 kf[4];
        LAS const unsigned char* kp = buf + ((sub * 32 + r) * KSTR + 8 * h) * 2;
#pragma unroll
        for (int ks = 0; ks < 4; ++ks) kf[ks] = *(LAS const bf16x8*)(kp + 32 * ks);
#pragma unroll
        for (int ks = 0; ks < 4; ++ks) s = MFMA32(kf[ks], qf[ks], s);
        __builtin_amdgcn_sched_barrier(0);
        float mx = -INFINITY;
        if (MASKED) {
#pragma unroll
            for (int i = 0; i < 16; ++i) { s[i] = key_valid<MODE>(key0 + 32 * sub + crow(i, h), t, selmask) ? s[i] : -INFINITY; mx = fmaxf(mx, s[i]); }
        } else {
#pragma unroll
            for (int i = 0; i < 16; ++i) mx = fmaxf(mx, s[i]);
        }
        mx = fmaxf(mx, __shfl_xor(mx, 32));
        const bool need = mx > m + 8.f;
        if (__any((int)need)) {
            const float mn = need ? mx : m;
            const float alpha = need ? __builtin_amdgcn_exp2f(m - mn) : 1.f;
            l *= alpha; m = mn;
#pragma unroll
            for (int db = 0; db < NDB; ++db)
#pragma unroll
                for (int i = 0; i < 16; ++i) o[db][i] *= alpha;
        }
        const float mu = (m == -INFINITY) ? 0.f : m;
        float ps = 0.f;
#pragma unroll
        for (int i = 0; i < 16; ++i) { s[i] = __builtin_amdgcn_exp2f(s[i] - mu); ps += s[i]; }
        l += ps;
#pragma unroll
        for (int sI = 0; sI < 2; ++sI) {
            u32x4 pb; pb.x = pk2(s[8 * sI + 0], s[8 * sI + 1]); pb.y = pk2(s[8 * sI + 2], s[8 * sI + 3]); pb.z = pk2(s[8 * sI + 4], s[8 * sI + 5]); pb.w = pk2(s[8 * sI + 6], s[8 * sI + 7]);
            const bf16x8 pbv = __builtin_bit_cast(bf16x8, pb);
#pragma unroll
            for (int db = 0; db < NDB; ++db) {
                LAS const unsigned char* vp = buf + KBUF_B + ((32 * db + r) * VSTR + 32 * sub + 16 * sI + 4 * h) * 2;
                const s16x4 lo = *(LAS const s16x4*)vp, hi = *(LAS const s16x4*)(vp + 16);
                const bf16x8 vf = __builtin_shufflevector(lo, hi, 0, 1, 2, 3, 4, 5, 6, 7);
                o[db] = MFMA32(vf, pbv, o[db]);
            }
        }
    }
}
template <int NDB, int MODE>
DI void flash_block(const bf16* Kg, const bf16* Vg, int ldv, unsigned tiles, LAS unsigned char* lds, const bf16x8 (&qf)[4], f32x16 (&o)[NDB], float& m, float& l,
                    int t, int qlo, int r, int h, unsigned selmask, int tid) {
    Stage<NDB / 2> st;
    unsigned rem = tiles; int cur = -1, bufi = 0;
    if (rem) { cur = __builtin_ctz(rem); rem &= rem - 1u; stage_load(st, Kg + (size_t)cur * 64 * 64, Vg + cur * 64, ldv, tid); }
    __syncthreads();
    while (cur >= 0) {
        LAS unsigned char* buf = lds + bufi * ABUF_B;
        stage_store(st, buf, tid);
        int nxt = -1;
        if (rem) { nxt = __builtin_ctz(rem); rem &= rem - 1u; stage_load(st, Kg + (size_t)nxt * 64 * 64, Vg + nxt * 64, ldv, tid); }
        __syncthreads();
        const int key0 = cur * 64;
        bool rel = true, msk = true;
        if (MODE == 0) { rel = key0 <= qlo + 31; msk = key0 + 63 > qlo; }
        if (MODE == 1) { rel = key0 <= qlo + 31 && key0 + 63 + 512 > qlo; msk = (key0 + 63 > qlo) || (key0 + 512 <= qlo + 31); }
        if (MODE == 2) { const int bit = (int)((selmask >> cur) & 1u); rel = key0 <= qlo + 31 && __any(bit); msk = (key0 + 63 > qlo) || !__all(bit); }
        if (rel) {
            if (msk) tile_compute<NDB, MODE, true>(buf, qf, o, m, l, key0, t, r, h, selmask);
            else tile_compute<NDB, MODE, false>(buf, qf, o, m, l, key0, t, r, h, selmask);
        }
        cur = nxt; bufi ^= 1;
    }
}

template <int MODE>
DI void flash_block2(const bf16* Kg, const bf16* Vg, int ldv, unsigned tiles, LAS unsigned char* lds, const bf16x8 (&qf)[4], f32x16 (&o)[2], float& m, float& l,
                     int t, int qlo, int r, int h, unsigned selmask, int tid) {
    Stage<1> st0, st1;
    unsigned rem = tiles; int c0 = -1, c1 = -1, bufi = 0;
    if (rem) { c0 = __builtin_ctz(rem); rem &= rem - 1u; stage_load(st0, Kg + (size_t)c0 * 64 * 64, Vg + c0 * 64, ldv, tid); }
    if (rem) { c1 = __builtin_ctz(rem); rem &= rem - 1u; stage_load(st1, Kg + (size_t)c1 * 64 * 64, Vg + c1 * 64, ldv, tid); }
    __syncthreads();
    while (c0 >= 0) {
        LAS unsigned char* bufa = lds + (2 * bufi) * NBUF_B;
        LAS unsigned char* bufb = bufa + NBUF_B;
        stage_store(st0, bufa, tid);
        if (c1 >= 0) stage_store(st1, bufb, tid);
        int n0 = -1, n1 = -1;
        if (rem) { n0 = __builtin_ctz(rem); rem &= rem - 1u; stage_load(st0, Kg + (size_t)n0 * 64 * 64, Vg + n0 * 64, ldv, tid); }
        if (rem) { n1 = __builtin_ctz(rem); rem &= rem - 1u; stage_load(st1, Kg + (size_t)n1 * 64 * 64, Vg + n1 * 64, ldv, tid); }
        __syncthreads();
#pragma unroll
        for (int half = 0; half < 2; ++half) {
            const int cur = half ? c1 : c0;
            if (cur < 0) continue;
            LAS unsigned char* buf = half ? bufb : bufa;
            const int key0 = cur * 64;
            bool rel = true, msk = true;
            if (MODE == 1) { rel = key0 <= qlo + 31 && key0 + 63 + 512 > qlo; msk = (key0 + 63 > qlo) || (key0 + 512 <= qlo + 31); }
            if (MODE == 2) { const int bit = (int)((selmask >> cur) & 1u); rel = key0 <= qlo + 31 && __any(bit); msk = (key0 + 63 > qlo) || !__all(bit); }
            if (rel) {
                if (msk) tile_compute<2, MODE, true>(buf, qf, o, m, l, key0, t, r, h, selmask);
                else tile_compute<2, MODE, false>(buf, qf, o, m, l, key0, t, r, h, selmask);
            }
        }
        c0 = n0; c1 = n1; bufi ^= 1;
    }
}

DI void diff_block(int b, int hh, int qb, float lam, const bf16* DQ, const bf16* DK, const bf16* DVT, const float* subln, bf16* AO, LAS unsigned char* lds, int wave, int lane, int tid) {
    const int r = lane & 31, h = lane >> 5, qlo = 256 * qb + 32 * wave, t = qlo + r;
    f32x16 o1[4];
    const bf16* Vg = DVT + (size_t)(b * 4 + hh) * 128 * 2048;
    const int ntile = 4 * qb + 4; const unsigned tiles = (ntile >= 32) ? 0xffffffffu : ((1u << ntile) - 1u);
    bf16* orow = AO + (size_t)(b * 2048 + t) * 1024 + hh * 128 + 4 * h;
    float ss = 0.f;
#pragma unroll 1
    for (int mm = 0; mm < 2; ++mm) {
        const size_t slab = ((size_t)((b * 4 + hh) * 2 + mm) * 2048) * 64;
        bf16x8 qf[4]; load_q(qf, DQ + slab + (size_t)t * 64 + 8 * h);
        float m = -INFINITY, l = 0.f;
        zero_o<4>(o1);
        flash_block<4, 0>(DK + slab, Vg, 2048, tiles, lds, qf, o1, m, l, t, qlo, r, h, 0u, tid);
        l += __shfl_xor(l, 32);
        const float inv = (l > 0.f) ? 1.f / l : 0.f;
        if (mm == 0) {
#pragma unroll
            for (int db = 0; db < 4; ++db)
#pragma unroll
                for (int a = 0; a < 4; ++a) {
                    u32x2 w; w.x = pk2(o1[db][4 * a + 0] * inv, o1[db][4 * a + 1] * inv); w.y = pk2(o1[db][4 * a + 2] * inv, o1[db][4 * a + 3] * inv);
                    *(u32x2*)(orow + 32 * db + 8 * a) = w;
                }
        } else {
            const float li = lam * inv;
#pragma unroll
            for (int db = 0; db < 4; ++db)
#pragma unroll
                for (int a = 0; a < 4; ++a) {
                    const u32x2 w = *(const u32x2*)(orow + 32 * db + 8 * a);
                    o1[db][4 * a + 0] = __builtin_bit_cast(float, w.x << 16) - li * o1[db][4 * a + 0];
                    o1[db][4 * a + 1] = __builtin_bit_cast(float, w.x & 0xffff0000u) - li * o1[db][4 * a + 1];
                    o1[db][4 * a + 2] = __builtin_bit_cast(float, w.y << 16) - li * o1[db][4 * a + 2];
                    o1[db][4 * a + 3] = __builtin_bit_cast(float, w.y & 0xffff0000u) - li * o1[db][4 * a + 3];
                    ss += (o1[db][4 * a + 0] * o1[db][4 * a + 0] + o1[db][4 * a + 1] * o1[db][4 * a + 1]) + (o1[db][4 * a + 2] * o1[db][4 * a + 2] + o1[db][4 * a + 3] * o1[db][4 * a + 3]);
                }
        }
    }
    ss += __shfl_xor(ss, 32);
    const float rs = __builtin_amdgcn_rsqf(ss * (1.f / 128.f) + EPS) * 0.8f;
#pragma unroll
    for (int db = 0; db < 4; ++db)
#pragma unroll
        for (int a = 0; a < 4; ++a) {
            const f32x4 g = *(const f32x4*)(subln + 32 * db + 8 * a + 4 * h);
            u32x2 w; w.x = pk2(o1[db][4 * a + 0] * rs * g[0], o1[db][4 * a + 1] * rs * g[1]); w.y = pk2(o1[db][4 * a + 2] * rs * g[2], o1[db][4 * a + 3] * rs * g[3]);
            *(u32x2*)(orow + 32 * db + 8 * a) = w;
        }
}

DI void nsa_block(int b, int g, int c, const bf16* NQ, const bf16* KC, const bf16* VCT, const bf16* KV6, const float* GATES, bf16* AO, LAS unsigned char* lds, int wave, int lane, int tid) {
    const int r = lane & 31, h = lane >> 5, hq = wave >> 1, qs = wave & 1, qlo = 64 * c + 32 * qs, t = qlo + r, bg = b * 2 + g, head = g * 4 + hq;
    const bf16* KCg = KC + (size_t)bg * 128 * 64;
    const bf16* VCg = VCT + (size_t)bg * 64 * 128;
    const size_t kvoff = (size_t)bg * 2048 * 64;
    bf16x8 qf[4]; load_q(qf, NQ + ((size_t)(b * 8 + head) * 2048 + t) * 64 + 8 * h);
    unsigned selmask, uni;
    const unsigned causal = (c >= 31) ? 0xffffffffu : ((2u << c) - 1u);
    if (c >= 16) {
    float imp[16];
    {
        const bf16* KCb = KCg + (size_t)r * 64 + 8 * h;
        f32x16 s[4]; float mx = -INFINITY;
#pragma unroll
        for (int T = 0; T < 4; ++T) {
            s[T] = qk_tile(KCb + (size_t)T * 32 * 64, qf);
            __builtin_amdgcn_sched_barrier(0);
#pragma unroll
            for (int i = 0; i < 16; ++i) { s[T][i] = key_valid<3>(32 * T + crow(i, h), t, 0u) ? s[T][i] : -INFINITY; mx = fmaxf(mx, s[T][i]); }
            __builtin_amdgcn_sched_barrier(0);
        }
        mx = fmaxf(mx, __shfl_xor(mx, 32));
        const float mu = (mx == -INFINITY) ? 0.f : mx;
        float ps = 0.f;
#pragma unroll
        for (int T = 0; T < 4; ++T)
#pragma unroll
            for (int i = 0; i < 16; ++i) { s[T][i] = __builtin_amdgcn_exp2f(s[T][i] - mu); ps += s[T][i]; }
        ps += __shfl_xor(ps, 32);
        const float inv = (ps > 0.f) ? 1.f / ps : 0.f;
        float xs[16];
#pragma unroll
        for (int idx = 0; idx < 16; ++idx) xs[idx] = __shfl_xor(s[idx >> 2][4 * (idx & 3) + 3], 32);
#pragma unroll
        for (int idx = 0; idx < 16; ++idx) {
            const int T = idx >> 2, a = idx & 3;
            const float w = s[T][4 * a] + s[T][4 * a + 1] + s[T][4 * a + 2] + 0.5f * s[T][4 * a + 3];
            const float cprev = (idx > 0) ? xs[idx > 0 ? idx - 1 : 0] : 0.f;
            const float carry = h ? xs[idx] : cprev;
            imp[idx] = (w + 0.5f * carry) * inv;
        }
    }
    LAS float* impx = (LAS float*)(lds + A_IMPX);
    LAS unsigned* misc = (LAS unsigned*)(lds + A_MISC);
#pragma unroll
    for (int idx = 0; idx < 16; ++idx) impx[(wave * 16 + idx) * 64 + lane] = imp[idx];
    if (tid == 0) misc[8] = 0u;
    __syncthreads();
#pragma unroll
    for (int idx = 0; idx < 16; ++idx) imp[idx] = (impx[((0 * 2 + qs) * 16 + idx) * 64 + lane] + impx[((1 * 2 + qs) * 16 + idx) * 64 + lane]) + (impx[((2 * 2 + qs) * 16 + idx) * 64 + lane] + impx[((3 * 2 + qs) * 16 + idx) * 64 + lane]);
    {
        const int cur = t >> 6;
        float val[16], oth[16];
#pragma unroll
        for (int idx = 0; idx < 16; ++idx) { const int j = 2 * idx + h; const bool forced = (j == 0) || (j == cur) || (j == cur - 1);
            val[idx] = forced ? 1e9f : ((j <= cur) ? imp[idx] : -1.f); }
#pragma unroll
        for (int idx = 0; idx < 16; ++idx) oth[idx] = __shfl_xor(val[idx], 32);
        unsigned bits = 0u;
#pragma unroll
        for (int idx = 0; idx < 16; ++idx) {
            const int j = 2 * idx + h; const float v = val[idx]; int rank = 0;
#pragma unroll
            for (int i2 = 0; i2 < 16; ++i2) {
                const int j2 = 2 * i2 + h, j3 = 2 * i2 + 1 - h;
                rank += (val[i2] > v || (val[i2] == v && j2 < j)) ? 1 : 0;
                rank += (oth[i2] > v || (oth[i2] == v && j3 < j)) ? 1 : 0;
                asm volatile("" : "+v"(rank));
            }
            bits |= (rank < 16) ? (1u << j) : 0u;
        }
        selmask = bits | (unsigned)__shfl_xor((int)bits, 32);
    }
    __hip_atomic_fetch_or((LAS unsigned*)&misc[8], selmask, __ATOMIC_RELAXED, __HIP_MEMORY_SCOPE_WORKGROUP);
    __syncthreads();
    uni = misc[8];
    uni = (unsigned)__builtin_amdgcn_readfirstlane((int)uni);
    } else { selmask = causal; uni = causal; }
    const float* gp = GATES + (size_t)(b * 2048 + t) * 24 + head * 3;
    const float g0 = gp[0], g1 = gp[1], g2 = gp[2];
    f32x16 out[2], o[2];
    zero_o<2>(out);
    {
        float m = -INFINITY, l = 0.f; zero_o<2>(o);
        flash_block2<3>(KCg, VCg, 128, 3u, lds, qf, o, m, l, t, qlo, r, h, 0u, tid);
        l += __shfl_xor(l, 32); const float f = (l > 0.f) ? g0 / l : 0.f;
#pragma unroll
        for (int db = 0; db < 2; ++db)
#pragma unroll
            for (int i = 0; i < 16; ++i) out[db][i] += f * o[db][i];
    }
    {
        float m = -INFINITY, l = 0.f; zero_o<2>(o);
        flash_block2<2>(KV6 + 2 * KVSLAB + kvoff, KV6 + 3 * KVSLAB + kvoff, 2048, uni & causal, lds, qf, o, m, l, t, qlo, r, h, selmask, tid);
        l += __shfl_xor(l, 32); const float f = (l > 0.f) ? g1 / l : 0.f;
#pragma unroll
        for (int db = 0; db < 2; ++db)
#pragma unroll
            for (int i = 0; i < 16; ++i) out[db][i] += f * o[db][i];
    }
    {
        float m = -INFINITY, l = 0.f; zero_o<2>(o);
        const unsigned lowm = (c > 8) ? ((1u << (c - 8)) - 1u) : 0u;
        flash_block2<1>(KV6 + 4 * KVSLAB + kvoff, KV6 + 5 * KVSLAB + kvoff, 2048, causal & ~lowm, lds, qf, o, m, l, t, qlo, r, h, 0u, tid);
        l += __shfl_xor(l, 32); const float f = (l > 0.f) ? g2 / l : 0.f;
#pragma unroll
        for (int db = 0; db < 2; ++db)
#pragma unroll
            for (int i = 0; i < 16; ++i) out[db][i] += f * o[db][i];
    }
    bf16* orow = AO + (size_t)(b * 2048 + t) * 1024 + 512 + head * 64 + 4 * h;
#pragma unroll
    for (int db = 0; db < 2; ++db)
#pragma unroll
        for (int a = 0; a < 4; ++a) {
            u32x2 w; w.x = pk2(out[db][4 * a + 0], out[db][4 * a + 1]); w.y = pk2(out[db][4 * a + 2], out[db][4 * a + 3]);
            *(u32x2*)(orow + 32 * db + 8 * a) = w;
        }
}

__global__ void __launch_bounds__(512) mega(Params p) {
    extern __shared__ __attribute__((aligned(16))) unsigned char lds_raw[];
    cg::grid_group grid = cg::this_grid();
    LAS unsigned char* lds = (LAS unsigned char*)lds_raw;
#define FRESH_IDS() int tid = threadIdx.x; asm volatile("" : "+v"(tid)); const int lane = tid & 63, wave = __builtin_amdgcn_readfirstlane(tid >> 6); const int gw = blockIdx.x * 8 + wave; (void)gw; (void)lane; (void)wave;
    const int G = gridDim.x, NGW = G * 8;
    unsigned char* ws = p.ws;
    unsigned* ctl = (unsigned*)(ws + WS_CTL);
    float* ROPE = (float*)(ws + WS_ROPE); float* CBIAS = (float*)(ws + WS_CBIAS); bf16* CW2 = (bf16*)(ws + WS_CW2); bf16* KC = (bf16*)(ws + WS_KC); bf16* VCT = (bf16*)(ws + WS_VCT);
    bf16* CW1 = (bf16*)(ws + WS_CW1); float* SSP = (float*)(ws + WS_SSP); float* GATES = (float*)(ws + WS_GATES);
    bf16* WOUT = (bf16*)(ws + WS_WOUT); bf16* WIN = (bf16*)(ws + WS_WIN); bf16* WGU1 = (bf16*)(ws + WS_WGU1); bf16* WD1 = (bf16*)(ws + WS_WD1); bf16* WGU2 = (bf16*)(ws + WS_WGU2); bf16* WD2 = (bf16*)(ws + WS_WD2);
    bf16* XR = (bf16*)(ws + WS_XR);
    float* RI = (float*)(ws + (52u << 20));
    bf16* XN = (bf16*)(ws + WS_XN); bf16* HD = (bf16*)(ws + WS_HD); bf16* HB = (bf16*)(ws + WS_HB);
    bf16* DQ = (bf16*)(ws + WS_DQ); bf16* DK = (bf16*)(ws + WS_DK); bf16* DVT = (bf16*)(ws + WS_DVT); bf16* NQ = (bf16*)(ws + WS_NQ); bf16* KV6 = (bf16*)(ws + WS_KV6);
    const float* x = p.in[0]; float* out = p.out;

    if (threadIdx.x < 64) ((LAS unsigned*)(lds + 131072))[threadIdx.x] = 0u;
    __syncthreads();
    XcdBarrier xbar = xcd_barrier_post((unsigned*)(ws + WS_BAR), (volatile LAS unsigned*)(lds + 131072));
#define GRID_SYNC() xcd_barrier(xbar)
    if (p.out == nullptr) grid.sync();
    {
        FRESH_IDS();
        if (blockIdx.x == 0 && tid < 64) ctl[tid] = 0u;
        LAS float* scr = (LAS float*)(lds + wave * 8448);
        constexpr int I_GU = 16 * 88, I_DN = 44 * 32, I_IN = 16 * 96, I_OUT = 16 * 32, I_C1 = 32 * 8, I_C2 = 4 * 2;
        constexpr int NITEMS = 4 * I_GU + 2 * I_DN + I_IN + I_OUT + 2 * I_C1 + 2 * I_C2;
        for (int it = gw; it < NITEMS; it += NGW) {
            int q = it;
            if (q < 4 * I_GU) {
                const int which = q / I_GU; q -= which * I_GU; const int kb = q / 88, nb = q % 88, n0 = 32 * nb;
                const float* W = p.in[which == 0 ? 2 : which == 1 ? 3 : which == 2 ? 22 : 23];
                bf16* dst = (which < 2) ? WGU1 : WGU2;
                transpose_item(W, 1024, FF, dst, 256 * (n0 >> 7) + (n0 & 127) + ((which & 1) ? 128 : 0), scr, 64 * kb, n0, lane, p.in[which < 2 ? 1 : 21]);
                continue;
            }
            q -= 4 * I_GU;
            if (q < 2 * I_DN) { const int which = q / I_DN; q -= which * I_DN; const int kb = q / 32, nb = q % 32;
                transpose_item(p.in[which ? 24 : 4], FF, 1024, which ? WD2 : WD1, 32 * nb, scr, 64 * kb, 32 * nb, lane); continue; }
            q -= 2 * I_DN;
            if (q < I_IN) { const int kb = q / 96, nb = q % 96; transpose_item(p.in[7], 1024, NIN, WIN, 32 * nb, scr, 64 * kb, 32 * nb, lane, p.in[6]); continue; }
            q -= I_IN;
            if (q < I_OUT) { const int kb = q / 32, nb = q % 32; transpose_item(p.in[19], 1024, 1024, WOUT, 32 * nb, scr, 64 * kb, 32 * nb, lane); continue; }
            q -= I_OUT;
            if (q < 2 * I_C1) { const int which = q / I_C1; q -= which * I_C1; const int kb = q / 8, nb = q % 8;
                transpose_item<true>(p.in[which ? 17 : 14], 2048, 256, CW1 + (size_t)which * 256 * 2048, 32 * nb, scr, 64 * kb, 32 * nb, lane); continue; }
            q -= 2 * I_C1;
            { const int which = q / I_C2; q -= which * I_C2; const int kb = q / 2, nb = q % 2;
              transpose_item(p.in[which ? 18 : 15], 256, 64, CW2 + (size_t)which * 64 * 256, 32 * nb, scr, 64 * kb, 32 * nb, lane); }
        }
        for (int i = blockIdx.x * 512 + tid; i < 2048 * 8; i += G * 512) {
            const int tt = i >> 3, e = i & 7;
            const double inv = exp2(-(double)e * (18.931568569324174 / 8.0));
            const double xr = (double)tt * inv * 0.15915494309189535;
            const double fr = xr - rint(xr);
            const float ang = (float)(fr * 6.283185307179586);
            ROPE[tt * 16 + e] = cosf(ang); ROPE[tt * 16 + 8 + e] = sinf(ang);
        }
        if ((int)blockIdx.x >= G - 16) {
            const int j = (G - 1) - (int)blockIdx.x, kv = j >> 3, sl = (j & 7) * 8 + wave;
            const float* pe = p.in[kv ? 16 : 13] + sl * 32; const float* w1 = p.in[kv ? 17 : 14] + (size_t)sl * 32 * 256;
            f32x4 a = {0.f, 0.f, 0.f, 0.f};
#pragma unroll
            for (int k = 0; k < 32; ++k) { const float pv = pe[k]; const f32x4 w = ((const f32x4*)(w1 + (size_t)k * 256))[lane]; a += pv * w; }
            ((f32x4*)(CBIAS + 1024 + (size_t)(kv * 64 + sl) * 256))[lane] = a;
        }
        rows_phase<false, 0, 0, true>(x, nullptr, nullptr, nullptr, 0.f, nullptr, nullptr, XN, RI, gw, NGW, lane);
    }
    GRID_SYNC();

#ifndef ONLY_ATT
#ifdef PROBE_SYNC
    for (int rep = 0; rep < 10; ++rep) GRID_SYNC();
#endif
#ifdef PROBE_P1
    for (int rep = 0; rep < 2; ++rep)
#endif
    { pg8::Gemm g{XN, WGU1, MROWS, NGU, DM}; pg8::StaticOrder S; S.init(MROWS, NGU, G, (int)blockIdx.x); pg8::EpiSwiglu E{HB, FF};
      pg8::gemm_phase<pg8::EpiSwiglu, pg8::StaticOrder, PG8_ALIGN_SW, true>(lds, g, S, E); }
    GRID_SYNC();
#ifdef PROBE_P2
    for (int rep = 0; rep < 2; ++rep)
#endif
    { pg8::Gemm g{HB, WD1, MROWS, DM, FF}; pg8::StaticOrder S; S.init(MROWS, DM, G, (int)blockIdx.x); pg8::EpiStoreSS E{HD, SSP};
      pg8::gemm_phase<pg8::EpiStoreSS, pg8::StaticOrder, true, true>(lds, g, S, E); }
    GRID_SYNC();
#ifdef PROBE_P3
    for (int rep = 0; rep < 2; ++rep)
#endif
    { FRESH_IDS();
      if (blockIdx.x == 0) { float s = 0.f; const float* pp = CBIAS + 1024 + (size_t)((tid >> 8) * 64) * 256 + (tid & 255);
#pragma unroll 16
          for (int q = 0; q < 64; ++q) s += pp[q * 256];
          CBIAS[tid] = s; }
      rows_phase<true, 1, 0, true>(XN, HD, SSP, p.in[5], 0.5f, nullptr, nullptr, XN, RI, gw, NGW, lane); }
    GRID_SYNC();
#ifdef PROBE_P4
    for (int rep = 0; rep < 2; ++rep)
#endif
    { pg8::Gemm g{XN, WIN, MROWS, NINP, DM}; pg8::StaticOrder S; S.init(MROWS, NINP, G, (int)blockIdx.x); pg8::EpiWin E{DQ, DK, DVT, NQ, KV6, GATES, ROPE};
      pg8::gemm_phase<pg8::EpiWin, pg8::StaticOrder, true, true>(lds, g, S, E); }
    GRID_SYNC();
#ifndef SKIP_CMP
#ifdef PROBE_P5
    for (int rep = 0; rep < 2; ++rep)
#endif
    { FRESH_IDS(); for (int u = blockIdx.x; u < 256; u += G) compress_unit(u, KV6, CW1, CBIAS, CW2, KC, VCT, lds, wave, lane, tid); }
#endif
    GRID_SYNC();
#endif
    {
        FRESH_IDS();
        float lam;
        { const float a = p.in[8][lane] * p.in[9][lane], c = p.in[10][lane] * p.in[11][lane];
          lam = __expf(wave_sum(a)) - __expf(wave_sum(c)) + 0.2f; }
        LAS unsigned* misc = (LAS unsigned*)(lds + A_MISC);
#ifdef PROBE_P6
        for (int rep = 0; rep < 2; ++rep)
#else
        const int rep = 0;
#endif
        {
#ifndef SKIP_DIFF
        for (;;) {
            __syncthreads();
            if (tid == 0) misc[0] = atomicAdd(ctl + 8 * rep, 1u);
            __syncthreads();
            const int u = __builtin_amdgcn_readfirstlane((int)misc[0]);
            if (u >= 512) break;
            int tidu = tid; asm volatile("" : "+v"(tidu));
            const int laneu = tidu & 63, waveu = __builtin_amdgcn_readfirstlane(tidu >> 6);
            const int idx = u & 63;
            diff_block(idx >> 2, idx & 3, 7 - (u >> 6), lam, DQ, DK, DVT, p.in[12], XR, lds, waveu, laneu, tidu);
        }
#endif
#ifndef SKIP_NSA
        for (;;) {
            __syncthreads();
            if (tid == 0) misc[0] = atomicAdd(ctl + 8 * rep + 4, 1u);
            __syncthreads();
            const int u = __builtin_amdgcn_readfirstlane((int)misc[0]);
            if (u >= 1024) break;
            int tidu = tid; asm volatile("" : "+v"(tidu));
            const int laneu = tidu & 63, waveu = __builtin_amdgcn_readfirstlane(tidu >> 6);
            const int idx = u & 31;
            nsa_block(idx >> 1, idx & 1, 31 - (u >> 5), NQ, KC, VCT, KV6, GATES, XR, lds, waveu, laneu, tidu);
        }
#endif
        }
    }
    GRID_SYNC();
#ifndef ONLY_ATT
    { pg8::Gemm g{XR, WOUT, MROWS, DM, DM}; pg8::StaticOrder S; S.init(MROWS, DM, G, (int)blockIdx.x); pg8::EpiStoreSS E{HD, SSP};
      pg8::gemm_phase<pg8::EpiStoreSS, pg8::StaticOrder, true, true>(lds, g, S, E); }
    GRID_SYNC();
    { FRESH_IDS(); rows_phase<true, 1, 0, true>(XN, HD, SSP, p.in[20], 1.0f, nullptr, nullptr, XN, RI, gw, NGW, lane); }
    GRID_SYNC();
    { pg8::Gemm g{XN, WGU2, MROWS, NGU, DM}; pg8::StaticOrder S; S.init(MROWS, NGU, G, (int)blockIdx.x); pg8::EpiSwiglu E{HB, FF};
      pg8::gemm_phase<pg8::EpiSwiglu, pg8::StaticOrder, PG8_ALIGN_SW, true>(lds, g, S, E); }
    GRID_SYNC();
    { pg8::Gemm g{HB, WD2, MROWS, DM, FF}; pg8::StaticOrder S; S.init(MROWS, DM, G, (int)blockIdx.x); pg8::EpiStoreSS E{HD, SSP};
      pg8::gemm_phase<pg8::EpiStoreSS, pg8::StaticOrder, true, true>(lds, g, S, E); }
    GRID_SYNC();
    { FRESH_IDS(); rows_phase<true, 1, 2, false>(XN, HD, SSP, p.in[25], 0.5f, out, nullptr, nullptr, RI, gw, NGW, lane); }
#endif
}

extern "C" void kernel_launch(void* const* d_in, const int* in_sizes, int n_in, void* d_out, int out_size, void* d_ws, size_t ws_size, hipStream_t stream) {
    static int grid_blocks = 0;
    if (!grid_blocks) {
        if (n_in != 26 || out_size != MROWS * DM || ws_size < WS_END) { fprintf(stderr, "kernel_launch: unexpected shapes n_in %d out %d ws %zu\n", n_in, out_size, ws_size); grid_blocks = -1; return; }
        int dev = 0, cus = 0, per_cu = 0;
        (void)hipGetDevice(&dev);
        (void)hipDeviceGetAttribute(&cus, hipDeviceAttributeMultiprocessorCount, dev);
        (void)hipFuncSetAttribute((const void*)mega, hipFuncAttributeMaxDynamicSharedMemorySize, LDS_BYTES);
        (void)hipOccupancyMaxActiveBlocksPerMultiprocessor(&per_cu, (const void*)mega, 512, LDS_BYTES);
        if (per_cu < 1) per_cu = 1;
        grid_blocks = cus * per_cu;
    }
    if (grid_blocks < 0) return;
    if (hipMemsetAsync((char*)d_ws + WS_BAR, 0, XCD_BAR_WORDS * sizeof(unsigned), stream) != hipSuccess) { fprintf(stderr, "kernel_launch: memset of the barrier words failed\n"); return; }
    Params p{};
    for (int i = 0; i < 26; ++i) p.in[i] = (const float*)d_in[i];
    p.out = (float*)d_out; p.ws = (unsigned char*)d_ws;
    void* args[] = {&p};
    hipError_t e = hipLaunchCooperativeKernel((void*)mega, dim3(grid_blocks), dim3(512), args, LDS_BYTES, stream);
    if (e != hipSuccess) fprintf(stderr, "cooperative launch failed: %s (grid %d)\n", hipGetErrorString(e), grid_blocks);
}
```

```cpp
#include <hip/hip_runtime.h>
#include <hip/hip_cooperative_groups.h>
#include <cstdio>
#include <cstdint>
namespace cg = cooperative_groups;
namespace pg8 {
#define PG8_LAS __attribute__((address_space(3)))
typedef unsigned short bf16_t;
typedef short bf16x8 __attribute__((ext_vector_type(8)));
typedef float f32x4 __attribute__((ext_vector_type(4)));
typedef unsigned u32x4 __attribute__((ext_vector_type(4)));
constexpr int BM = 256, BK = 64, HALF = 128, HTB = HALF * BK * 2  , STAGE_BYTES = 8 * HTB, NXCD = 8, WGM = 8;

__host__ __device__ __forceinline__ int lds_byte(int r, int c) { const int st = (r >> 4) * 2 + (c >> 5), rr = r & 15, cc = c & 31, ob = rr * 64 + cc * 2; return st * 1024 + (ob ^ (((ob >> 9) & 1) << 5)); }
__host__ __device__ __forceinline__ void stage_rc(int b, int& R, int& C) { const int st = b / 1024, sb = b % 1024, swz = sb ^ (((sb >> 9) & 1) << 5); R = (st >> 1) * 16 + swz / 64; C = (st & 1) * 32 + (swz % 64) / 2; }
__host__ __device__ __forceinline__ int perm32(int rho) { const int n = rho >> 4, i = rho & 15; return 8 * (i >> 2) + 4 * n + (i & 3); }

struct Unit { int pm, pn; };
struct Gemm { const bf16_t* A; const bf16_t* Bt; int M, N, K; };

struct StaticOrder {
    int nM, nN, nwg, G, c;
    __host__ __device__ void init(int M, int N, int G_, int c_) { nM = M / BM; nN = N / BM; nwg = nM * nN; G = G_; c = c_; }
    __host__ __device__ bool next(int i, Unit& u) const {
        const long L = (long)i * G + c; if (L >= nwg) return false;
        int wgid = (int)L; { const int q = nwg / NXCD, r = nwg % NXCD, xcd = wgid % NXCD, off = wgid / NXCD; wgid = (xcd < r ? xcd * (q + 1) : r * (q + 1) + (xcd - r) * q) + off; }
        const int nig = WGM * nN, gid = wgid / nig, fm = gid * WGM, gsz = (nM - fm) < WGM ? (nM - fm) : WGM;
        u.pm = fm + ((wgid % nig) % gsz); u.pn = (wgid % nig) / gsz; return true;
    }
    __device__ __forceinline__ void a_ready(const Unit&) const {}
    __device__ __forceinline__ void done(const Unit&) const {}
};


typedef float f32x2 __attribute__((ext_vector_type(2)));
typedef __bf16 bf16x2v __attribute__((ext_vector_type(2)));
__device__ __forceinline__ unsigned cvt_pk_bf16(float lo, float hi) { f32x2 v = {lo, hi}; bf16x2v b = __builtin_convertvector(v, bf16x2v); return __builtin_bit_cast(unsigned, b); }
__device__ __forceinline__ unsigned short cvt_bf16(float x) { return (unsigned short)(cvt_pk_bf16(x, 0.f) & 0xffffu); }
__device__ __forceinline__ float fast_sigmoid(float x) { return __builtin_amdgcn_rcpf(1.f + __builtin_amdgcn_exp2f(-1.4426950408889634f * x)); }
__device__ __forceinline__ void st8(bf16_t* p, const float* v) { u32x4 w; w.x = cvt_pk_bf16(v[0], v[1]); w.y = cvt_pk_bf16(v[2], v[3]); w.z = cvt_pk_bf16(v[4], v[5]); w.w = cvt_pk_bf16(v[6], v[7]); *(u32x4*)p = w; }

struct EpiSwiglu {
    static constexpr bool PERM = true, AFTER_DRAIN = false;
    bf16_t* O; int ldc;
    __device__ __forceinline__ void operator()(const f32x4 (&acc)[2][2][4][2], const Unit& u, int wr, int wc, int fr, int fq) const {
        const int row0 = u.pm * BM + wr * 64 + fr, col0 = u.pn * HALF + wc * 32 + 8 * fq;
#pragma unroll
        for (int ai = 0; ai < 2; ++ai)
#pragma unroll
            for (int m = 0; m < 4; ++m) {
                float v[8];
#pragma unroll
                for (int n = 0; n < 2; ++n)
#pragma unroll
                    for (int e = 0; e < 4; ++e) { const float g = acc[ai][0][m][n][e], up = acc[ai][1][m][n][e]; v[4 * n + e] = g * fast_sigmoid(g) * up; }
                { u32x4 w; w.x = cvt_pk_bf16(v[0], v[1]); w.y = cvt_pk_bf16(v[2], v[3]); w.z = cvt_pk_bf16(v[4], v[5]); w.w = cvt_pk_bf16(v[6], v[7]); __builtin_nontemporal_store(w, (u32x4*)(O + (size_t)(row0 + ai * HALF + m * 16) * ldc + col0)); }
            }
    }
};

struct EpiStoreSS {
    static constexpr bool PERM = true, AFTER_DRAIN = false;
    bf16_t* O; float* SSP;
    __device__ __forceinline__ void operator()(const f32x4 (&acc)[2][2][4][2], const Unit& u, int wr, int wc, int fr, int fq) const {
        const int row0 = u.pm * BM + wr * 64 + fr, col0 = u.pn * BM + wc * 32 + 8 * fq;
#pragma unroll
        for (int ai = 0; ai < 2; ++ai)
#pragma unroll
            for (int m = 0; m < 4; ++m) {
                const int row = row0 + ai * HALF + m * 16; float ss = 0.f;
#pragma unroll
                for (int bj = 0; bj < 2; ++bj) {
                    float v[8];
#pragma unroll
                    for (int n = 0; n < 2; ++n)
#pragma unroll
                        for (int e = 0; e < 4; ++e) { v[4 * n + e] = acc[ai][bj][m][n][e]; ss += v[4 * n + e] * v[4 * n + e]; }
                    st8(O + (size_t)row * 1024 + col0 + bj * HALF, v);
                }
                ss += __shfl_xor(ss, 16); ss += __shfl_xor(ss, 32);
                if (fq == 0) SSP[(size_t)row * 16 + u.pn * 4 + wc] = ss;
            }
    }
};

struct EpiWin {
    static constexpr bool PERM = true, AFTER_DRAIN = false;
    bf16_t *DQ, *DK, *DVT, *NQ, *KV6;
    float* GATES; const float* ROPE;
    __device__ __forceinline__ void operator()(const f32x4 (&acc)[2][2][4][2], const Unit& u, int wr, int wc, int fr, int fq) const {
        const int row0 = u.pm * BM + wr * 64 + fr;
#pragma unroll
        for (int bj = 0; bj < 2; ++bj) {
            const int cb = u.pn * BM + bj * HALF;
            const int col0 = cb + wc * 32 + 8 * fq;
            int kind; bf16_t* base = nullptr; int heads = 1, dshift = 6, c = 0;
            if (cb < 512)       { kind = 1; base = DQ;  c = col0; }
            else if (cb < 1024) { kind = 1; base = DK;  c = col0 - 512; }
            else if (cb < 1536) { kind = 2; base = DVT; c = col0 - 1024; heads = 4; dshift = 7; }
            else if (cb < 2048) { kind = 1; base = NQ;  c = col0 - 1536; }
            else if (cb < 2816) { const int idx = (cb - 2048) >> 7; base = KV6 + (size_t)idx * (16 * 2 * 2048 * 64); c = col0 - cb; heads = 2; dshift = 6;
                                  kind = (idx == 2 || idx == 4) ? 1 : ((idx == 3 || idx == 5) ? 2 : 0); }
            else if (cb == 2816) { kind = 3; c = col0 - 2816; }
            else { kind = 4; }
            if (kind == 4) continue;
            const float qsc = (cb < 512 || (cb >= 1536 && cb < 2048)) ? 0.18033688011112042f : 1.f;
            const int d0 = c & ((1 << dshift) - 1), hd = c >> dshift;
            int slabs = 8;
            if (cb >= 2048) slabs = 2;
#pragma unroll
            for (int ai = 0; ai < 2; ++ai)
#pragma unroll
                for (int m = 0; m < 4; ++m) {
                    const int row = row0 + ai * HALF + m * 16, b = row >> 11, t = row & 2047;
                    float v[8];
#pragma unroll
                    for (int n = 0; n < 2; ++n)
#pragma unroll
                        for (int e = 0; e < 4; ++e) v[4 * n + e] = acc[ai][bj][m][n][e] * qsc;
                    if (kind == 1) {
                        float pv[8];
#pragma unroll
                        for (int e = 0; e < 8; ++e) pv[e] = __shfl_xor(v[e], 16);
                        if (d0 < 16) {
                            const f32x4* cs = (const f32x4*)(ROPE + t * 16);
                            const f32x4 c0 = cs[0], c1 = cs[1], s0 = cs[2], s1 = cs[3];
                            const float sg = (d0 == 0) ? -1.f : 1.f;
#pragma unroll
                            for (int e = 0; e < 4; ++e) { v[e] = v[e] * c0[e] + sg * pv[e] * s0[e]; v[4 + e] = v[4 + e] * c1[e] + sg * pv[4 + e] * s1[e]; }
                        }
                    }
                    if (kind <= 1) {
                        st8(base + (((size_t)(b * slabs + hd) * 2048 + t) << 6) + d0, v);
                    } else if (kind == 2) {
                        bf16_t* p = base + ((size_t)((b * heads + hd) << dshift) + d0) * 2048 + t;
#pragma unroll
                        for (int e = 0; e < 8; ++e) p[(size_t)e * 2048] = cvt_bf16(v[e]);
                    } else {
                        if (c < 24) {
#pragma unroll
                            for (int e = 0; e < 8; ++e) GATES[(size_t)row * 24 + c + e] = fast_sigmoid(v[e]);
                        }
                    }
                }
        }
    }
};

template <class Epi, class Sched, bool ALIGN_EPI = false, bool SP2 = false>
__device__ __forceinline__ void gemm_phase(PG8_LAS unsigned char* lds, const Gemm g, const Sched& S, const Epi& E) {
    int tid_l = threadIdx.x; asm volatile("" : "+v"(tid_l));
    const int tid = tid_l, wid = __builtin_amdgcn_readfirstlane(tid >> 6), lane = tid & 63, wr = wid >> 2, wc = wid & 3, fr = lane & 15, fq = lane >> 4;
    const int K = g.K, nt = K / BK;
    unsigned voffA[2], voffB[2];
#pragma unroll
    for (int i = 0; i < 2; ++i) { int R, C; stage_rc(tid * 16 + i * 8192, R, C); const int Rb = Epi::PERM ? ((R & ~31) + perm32(R & 31)) : R;
        voffA[i] = (unsigned)(R * K + C) * 2u; voffB[i] = (unsigned)(Rb * K + C) * 2u; }
    const size_t kstep = (size_t)(BK * 2);
    const size_t hstep = (size_t)HALF * K * 2;
    const size_t tstep = 2 * hstep;
    const unsigned ldsw = (unsigned)wid * 1024u;
    const int aoff = lds_byte(wr * 64 + fr, fq * 8), boff = lds_byte(wc * 32 + fr, fq * 8);
#define PG8_SA(b, h) (((b) * 2 + (h)) * HTB)
#define PG8_SB(b, h) ((4 + (b) * 2 + (h)) * HTB)
#define PG8_STAGE(bufoff, gbase, voff) do { _Pragma("unroll") for (int _i = 0; _i < 2; ++_i) \
        __builtin_amdgcn_global_load_lds((const unsigned*)((const char*)(gbase) + (voff)[_i]), (PG8_LAS unsigned*)(lds + (bufoff) + ldsw + _i * 8192), 16, 0, 0); } while (0)
#define PG8_LDA(dst, b, h) do { _Pragma("unroll") for (int m = 0; m < 4; ++m) _Pragma("unroll") for (int k = 0; k < 2; ++k) dst[m][k] = *(const PG8_LAS bf16x8*)(lds + PG8_SA(b, h) + aoff + m * 2048 + k * 1024); } while (0)
#define PG8_LDB(dst, b, h) do { _Pragma("unroll") for (int n = 0; n < 2; ++n) _Pragma("unroll") for (int k = 0; k < 2; ++k) dst[n][k] = *(const PG8_LAS bf16x8*)(lds + PG8_SB(b, h) + boff + n * 2048 + k * 1024); } while (0)
#define PG8_MMA(ai, bj, At, Bt) do { __builtin_amdgcn_s_setprio(1); _Pragma("unroll") for (int m = 0; m < 4; ++m) _Pragma("unroll") for (int n = 0; n < 2; ++n) _Pragma("unroll") for (int k = 0; k < 2; ++k) \
        acc[ai][bj][m][n] = __builtin_amdgcn_mfma_f32_16x16x32_bf16(Bt[n][k], At[m][k], acc[ai][bj][m][n], 0, 0, 0); __builtin_amdgcn_s_setprio(0); } while (0)
#define PG8_WAIT_V(n) asm volatile("s_waitcnt vmcnt(" #n ")" ::: "memory")
#define PG8_WAIT_L(n) asm volatile("s_waitcnt lgkmcnt(" #n ")" ::: "memory")
#define PG8_BAR __builtin_amdgcn_s_barrier()
#define PG8_SCHED __builtin_amdgcn_sched_barrier(0)
    Unit cur, nxt; int ui = 0;
    if (!S.next(0, cur)) return;
    f32x4 acc[2][2][4][2];
#pragma unroll
    for (int a = 0; a < 2; ++a)
#pragma unroll
        for (int b = 0; b < 2; ++b)
#pragma unroll
            for (int m = 0; m < 4; ++m)
#pragma unroll
                for (int n = 0; n < 2; ++n) acc[a][b][m][n] = (f32x4){0.f, 0.f, 0.f, 0.f};
    bf16x8 At[4][2], B0[2][2], B1[2][2];
    const char* cA = (const char*)g.A + (size_t)cur.pm * tstep; const char* cB = (const char*)g.Bt + (size_t)cur.pn * tstep;
    S.a_ready(cur);
    if constexpr (SP2) {
        PG8_STAGE(PG8_SB(0, 0), cB, voffB); PG8_STAGE(PG8_SB(0, 1), cB + hstep, voffB); PG8_STAGE(PG8_SA(0, 0), cA, voffA); PG8_STAGE(PG8_SA(0, 1), cA + hstep, voffA);
        if (wr == 1) PG8_BAR;
        PG8_WAIT_V(2); PG8_BAR;
        PG8_STAGE(PG8_SB(1, 0), cB + kstep, voffB); PG8_STAGE(PG8_SA(1, 0), cA + kstep, voffA); PG8_STAGE(PG8_SB(1, 1), cB + hstep + kstep, voffB);
        PG8_WAIT_V(6); PG8_BAR;
    } else {
        PG8_STAGE(PG8_SB(0, 0), cB, voffB); PG8_STAGE(PG8_SA(0, 0), cA, voffA); PG8_STAGE(PG8_SB(0, 1), cB + hstep, voffB); PG8_STAGE(PG8_SA(0, 1), cA + hstep, voffA);
        if (wr == 1) PG8_BAR;
        PG8_WAIT_V(4); PG8_BAR;
        PG8_STAGE(PG8_SB(1, 0), cB + kstep, voffB); PG8_STAGE(PG8_SA(1, 0), cA + kstep, voffA); PG8_STAGE(PG8_SB(1, 1), cB + hstep + kstep, voffB);
        PG8_WAIT_V(6); PG8_BAR;
    }
    for (;;) {
        const bool has_next = S.next(ui + 1, nxt);
        const char* nA = has_next ? (const char*)g.A + (size_t)nxt.pm * tstep : cA; const char* nB = has_next ? (const char*)g.Bt + (size_t)nxt.pn * tstep : cB;
        for (int t = 0; t < nt; t += 2) {
            const bool last = (t == nt - 2);
            const char* a1 = cA + (size_t)(t + 1) * kstep;
            const char* a2 = last ? nA : cA + (size_t)(t + 2) * kstep; const char* b2 = last ? nB : cB + (size_t)(t + 2) * kstep;
            const char* a3 = a2 + kstep; const char* b3 = b2 + kstep;
            if (last && has_next) S.a_ready(nxt);
            if constexpr (SP2) {
            PG8_LDB(B0, 0, 0); PG8_LDB(B1, 0, 1); PG8_SCHED; PG8_LDA(At, 0, 0); PG8_STAGE(PG8_SA(1, 1), a1 + hstep, voffA);
            PG8_WAIT_V(8); PG8_WAIT_L(0); PG8_BAR; PG8_MMA(0, 0, At, B0); PG8_MMA(0, 1, At, B1); PG8_BAR; PG8_SCHED;
            PG8_LDA(At, 0, 1); PG8_STAGE(PG8_SB(0, 0), b2, voffB); PG8_STAGE(PG8_SB(0, 1), b2 + hstep, voffB); PG8_STAGE(PG8_SA(0, 0), a2, voffA);
            PG8_WAIT_V(8); PG8_WAIT_L(0); PG8_BAR; PG8_MMA(1, 0, At, B0); PG8_MMA(1, 1, At, B1); PG8_BAR; PG8_SCHED;
            PG8_LDB(B0, 1, 0); PG8_LDB(B1, 1, 1); PG8_SCHED; PG8_LDA(At, 1, 0); PG8_STAGE(PG8_SA(0, 1), a2 + hstep, voffA);
            PG8_WAIT_V(8); PG8_WAIT_L(0); PG8_BAR; PG8_MMA(0, 0, At, B0); PG8_MMA(0, 1, At, B1); PG8_BAR; PG8_SCHED;
            PG8_LDA(At, 1, 1); PG8_STAGE(PG8_SB(1, 0), b3, voffB); PG8_STAGE(PG8_SB(1, 1), b3 + hstep, voffB); PG8_STAGE(PG8_SA(1, 0), a3, voffA);
            PG8_WAIT_V(8); PG8_WAIT_L(0); PG8_BAR; PG8_MMA(1, 0, At, B0); PG8_MMA(1, 1, At, B1); PG8_BAR; PG8_SCHED;
            } else {
            PG8_LDB(B0, 0, 0); PG8_SCHED; PG8_LDA(At, 0, 0); PG8_STAGE(PG8_SA(1, 1), a1 + hstep, voffA);
            PG8_WAIT_L(8); PG8_BAR; PG8_WAIT_L(0); PG8_MMA(0, 0, At, B0); PG8_BAR; PG8_SCHED;
            PG8_LDB(B1, 0, 1); PG8_STAGE(PG8_SB(0, 0), b2, voffB);
            PG8_BAR; PG8_WAIT_L(0); PG8_MMA(0, 1, At, B1); PG8_BAR;
            PG8_LDA(At, 0, 1); PG8_STAGE(PG8_SA(0, 0), a2, voffA);
            PG8_BAR; PG8_WAIT_L(0); PG8_MMA(1, 0, At, B0); PG8_BAR; PG8_SCHED;
            PG8_STAGE(PG8_SB(0, 1), b2 + hstep, voffB);
            PG8_WAIT_V(6); PG8_BAR; PG8_MMA(1, 1, At, B1); PG8_BAR;
            PG8_LDB(B0, 1, 0); PG8_SCHED; PG8_LDA(At, 1, 0); PG8_STAGE(PG8_SA(0, 1), a2 + hstep, voffA);
            PG8_WAIT_L(8); PG8_BAR; PG8_WAIT_L(0); PG8_MMA(0, 0, At, B0); PG8_BAR; PG8_SCHED;
            PG8_LDB(B1, 1, 1); PG8_STAGE(PG8_SB(1, 0), b3, voffB);
            PG8_BAR; PG8_WAIT_L(0); PG8_MMA(0, 1, At, B1); PG8_BAR;
            PG8_LDA(At, 1, 1); PG8_STAGE(PG8_SA(1, 0), a3, voffA);
            PG8_BAR; PG8_WAIT_L(0); PG8_MMA(1, 0, At, B0); PG8_BAR; PG8_SCHED;
            PG8_STAGE(PG8_SB(1, 1), b3 + hstep, voffB);
            PG8_WAIT_V(6); PG8_BAR; PG8_MMA(1, 1, At, B1); PG8_BAR;
            }
        }
        if constexpr (ALIGN_EPI) { if (wr == 0) PG8_BAR; }
        if constexpr (!Epi::AFTER_DRAIN) { E(acc, cur, wr, wc, fr, fq); S.done(cur); }
        if (!has_next) break;
#pragma unroll
        for (int a = 0; a < 2; ++a)
#pragma unroll
            for (int b = 0; b < 2; ++b)
#pragma unroll
                for (int m = 0; m < 4; ++m)
#pragma unroll
                    for (int n = 0; n < 2; ++n) acc[a][b][m][n] = (f32x4){0.f, 0.f, 0.f, 0.f};
        cur = nxt; cA = nA; cB = nB; ++ui;
        if constexpr (ALIGN_EPI) { if (wr == 1) PG8_BAR; }
    }
    PG8_WAIT_V(0);
    if constexpr (!ALIGN_EPI) { if (wr == 0) PG8_BAR; }
    PG8_BAR;
    if constexpr (Epi::AFTER_DRAIN) { E.fused(acc, cur, wr, wc, fr, fq, lds, wid, lane); S.done(cur); }
#undef PG8_SA
#undef PG8_SB
#undef PG8_STAGE
#undef PG8_LDA
#undef PG8_LDB
#undef PG8_MMA
#undef PG8_WAIT_V
#undef PG8_WAIT_L
#undef PG8_BAR
#undef PG8_SCHED
}
}

#define DI __device__ __forceinline__
#define LAS __attribute__((address_space(3)))
typedef unsigned short bf16;
typedef short bf16x8 __attribute__((ext_vector_type(8)));
typedef short s16x4 __attribute__((ext_vector_type(4)));
typedef float f32x4 __attribute__((ext_vector_type(4)));
typedef float f32x16 __attribute__((ext_vector_type(16)));
typedef unsigned u32x2 __attribute__((ext_vector_type(2)));
typedef unsigned u32x4 __attribute__((ext_vector_type(4)));

constexpr int NB = 16, SQ = 2048, DM = 1024, MROWS = NB * SQ, FF = 2816, NGU = 2 * FF, NIN = 2840, NINP = 3072;
constexpr float EPS = 1e-6f;
constexpr size_t MiB = 1u << 20;
constexpr size_t WS_CTL = 0, WS_ROPE = 1 * MiB, WS_CBIAS = 1 * MiB + 256 * 1024, WS_CW2 = 1 * MiB + 512 * 1024, WS_KC = 2 * MiB, WS_VCT = 2 * MiB + 512 * 1024,
                 WS_CW1 = 3 * MiB, WS_SSP = 5 * MiB, WS_GATES = 7 * MiB, WS_WOUT = 10 * MiB, WS_WIN = 12 * MiB, WS_WGU1 = 18 * MiB, WS_WD1 = 29 * MiB,
                 WS_WGU2 = 35 * MiB, WS_WD2 = 46 * MiB, WS_XN = 64 * MiB, WS_HD = 128 * MiB, WS_HB = 192 * MiB,
                 WS_DQ = 192 * MiB, WS_DK = 224 * MiB, WS_DVT = 256 * MiB, WS_NQ = 288 * MiB, WS_KV6 = 320 * MiB, WS_XR = 370 * MiB, WS_END = 436 * MiB;
constexpr size_t KVSLAB = (size_t)16 * 2 * 2048 * 64;
constexpr int LDS_BYTES = 131072 + 256;
constexpr size_t WS_BAR = 64 * 1024;
constexpr float SCL2 = 0.125f * 1.4426950408889634f;

#ifndef PG8_ALIGN_SW
#define PG8_ALIGN_SW true
#endif
struct Params { const float* in[26]; float* out; unsigned char* ws; };

DI float wave_sum(float v) {
#pragma unroll
    for (int o = 1; o < 64; o <<= 1) v += __shfl_xor(v, o);
    return v;
}
DI unsigned pk2(float lo, float hi) { return pg8::cvt_pk_bf16(lo, hi); }
DI float bf2f(unsigned short b) { return __builtin_bit_cast(float, (unsigned)b << 16); }
#define MFMA32(a, b, c) __builtin_amdgcn_mfma_f32_32x32x16_bf16((a), (b), (c), 0, 0, 0)
DI int crow(int i, int h) { return (i & 3) + 8 * (i >> 2) + 4 * h; }

#define XB_TMO      128
#define XB_XCNT(j)  (256  + 64 * (j))
#define XB_XSUB(j)  (1280 + 64 * (j))
#define XB_XGEN(j)  (2304 + 64 * (j))
#define XB_TOP      3328
#define XB_TOPGEN   3392
#define XCD_BAR_WORDS 3456
#define XB_SPIN_CAP (1u << 18)

__device__ __forceinline__ unsigned xb_ld(unsigned* p)              { return __hip_atomic_load(p, __ATOMIC_RELAXED, __HIP_MEMORY_SCOPE_AGENT); }
__device__ __forceinline__ unsigned xb_add(unsigned* p, unsigned v) { return __hip_atomic_fetch_add(p, v, __ATOMIC_RELAXED, __HIP_MEMORY_SCOPE_AGENT); }
__device__ __forceinline__ unsigned xb_xcc_id() { return (unsigned)__builtin_amdgcn_s_getreg((3 << 11) | 20) & 0xFu; }
#define XB_SPIN(cond, bar) do { unsigned _sp = 0; while (cond) { __builtin_amdgcn_s_sleep(1); \
    if ((++_sp & 255u) == 0u) { if (xb_ld(&(bar)[XB_TMO])) break; if (_sp > XB_SPIN_CAP) { atomicAdd(&(bar)[XB_TMO], 1u); break; } } } } while (0)

struct XcdBarrier {
    unsigned* bar; unsigned x;
    volatile LAS unsigned* st;
};

__device__ __forceinline__ XcdBarrier xcd_barrier_post(unsigned* bar, volatile LAS unsigned* st) {
    XcdBarrier b; b.bar = bar; b.x = xb_xcc_id(); b.st = st;
    if (threadIdx.x == 0) (void)xb_add(&bar[XB_XCNT(b.x)], 1u);
    return b;
}
__device__ __forceinline__ void xcd_barrier_complete(unsigned* bar, unsigned x, unsigned& nloc, unsigned& nx) {
    const unsigned G = gridDim.x * gridDim.y * gridDim.z;
    unsigned sum, cnt, mine, sp = 0u;
    for (;;) {
        sum = 0u; cnt = 0u; mine = 0u;
#pragma unroll
        for (unsigned j = 0; j < 16; ++j) { const unsigned c = xb_ld(&bar[XB_XCNT(j)]); sum += c; cnt += (c > 0u) ? 1u : 0u; mine = (j == x) ? c : mine; }
        if (sum == G) break;
        __builtin_amdgcn_s_sleep(1);
        if ((++sp & 255u) == 0u) { if (xb_ld(&bar[XB_TMO])) break; if (sp > XB_SPIN_CAP) { atomicAdd(&bar[XB_TMO], 1u); break; } }
    }
    nloc = mine > 0u ? mine : 1u; nx = cnt > 0u ? cnt : 1u;
}

__device__ __forceinline__ void xcd_barrier(const XcdBarrier& b) {
    asm volatile("s_waitcnt vmcnt(0)" ::: "memory");
    __syncthreads();
    if (threadIdx.x == 0) {
        unsigned* bar = b.bar;
        __builtin_amdgcn_s_waitcnt(0);
        unsigned nloc = b.st[0], nx = b.st[1];
        if (nloc == 0u) { xcd_barrier_complete(bar, b.x, nloc, nx); b.st[0] = nloc; b.st[1] = nx; }
        const unsigned old = xb_add(&bar[XB_XSUB(b.x)], 1u);
        const unsigned gen = old / nloc;
        if (old + 1u == (gen + 1u) * nloc) {
            __builtin_amdgcn_fence(__ATOMIC_RELEASE, "agent");
            asm volatile("s_waitcnt vmcnt(0)" ::: "memory");
            const unsigned og = xb_add(&bar[XB_TOP], 1u);
            const unsigned tg = og / nx;
            if (og + 1u == (tg + 1u) * nx) xb_add(&bar[XB_TOPGEN], 1u);
            else XB_SPIN(xb_ld(&bar[XB_TOPGEN]) == tg, bar);
            __builtin_amdgcn_fence(__ATOMIC_ACQUIRE, "agent");
            xb_add(&bar[XB_XGEN(b.x)], 1u);
            asm volatile("s_waitcnt vmcnt(0)" ::: "memory");
        } else {
            XB_SPIN(xb_ld(&bar[XB_XGEN(b.x)]) == gen, bar);
            __builtin_amdgcn_fence(__ATOMIC_ACQUIRE, "agent");
            asm volatile("s_waitcnt vmcnt(0)" ::: "memory");
        }
    }
    __syncthreads();
}

template <bool FRAG = false>
DI void transpose_item(const float* W, int K, int N, bf16* WT, int destrow0, LAS float* scr, int k0, int n0, int lane, const float* gk = nullptr) {
    const int col = n0 + (lane & 31);
#pragma unroll
    for (int i = 0; i < 32; ++i) { const int kk = 2 * i + (lane >> 5); scr[kk * 33 + (lane & 31)] = (col < N) ? __builtin_nontemporal_load(W + (size_t)(k0 + kk) * N + col) : 0.f; }
    asm volatile("s_waitcnt lgkmcnt(0)" ::: "memory");
    const int c = lane & 7;
    f32x4 ga = {1.f, 1.f, 1.f, 1.f}, gb = ga;
    if (gk) { ga = *(const f32x4*)(gk + k0 + 8 * c); gb = *(const f32x4*)(gk + k0 + 8 * c + 4); }
#pragma unroll
    for (int j = 0; j < 4; ++j) { const int n = (lane >> 3) + 8 * j; const LAS float* s = scr + (8 * c) * 33 + n;
        u32x4 o; o.x = pk2(s[0 * 33] * ga[0], s[1 * 33] * ga[1]); o.y = pk2(s[2 * 33] * ga[2], s[3 * 33] * ga[3]); o.z = pk2(s[4 * 33] * gb[0], s[5 * 33] * gb[1]); o.w = pk2(s[6 * 33] * gb[2], s[7 * 33] * gb[3]);
        if (FRAG) {
            const int nn = destrow0 + n, kk = k0 + 8 * c;
            *(u32x4*)(WT + ((size_t)(((nn >> 5) * (K >> 4) + (kk >> 4)) * 64 + ((kk >> 3) & 1) * 32 + (nn & 31)) << 3)) = o;
        } else *(u32x4*)(WT + (size_t)(destrow0 + n) * K + k0 + 8 * c) = o; }
    asm volatile("s_waitcnt lgkmcnt(0)" ::: "memory");
}

template <bool HAS_H, int XIN, int XOUT, bool WRITE_XN>
DI void rows_phase(const void* xin_, const bf16* HD, const float* SSP, const float* gpost, float sc, void* xout_, const float* gpre, bf16* XN, float* RI, int gw, int NGW, int lane) {
    for (int m0 = gw; m0 < MROWS; m0 += 2 * NGW) {
        f32x4 v[2][4]; u32x2 hb[2][4]; f32x4 sp[2][4];
#pragma unroll
        for (int rr = 0; rr < 2; ++rr) {
            const int m = m0 + rr * NGW;
            if (XIN == 0) {
                const f32x4* xr = (const f32x4*)((const float*)xin_ + (size_t)m * DM) + lane;
#pragma unroll
                for (int j = 0; j < 4; ++j) v[rr][j] = __builtin_nontemporal_load(xr + 64 * j);
            } else {
                const u32x2* xr = (const u32x2*)((const bf16*)xin_ + (size_t)m * DM) + lane;
                const float ri = RI[m];
#pragma unroll
                for (int j = 0; j < 4; ++j) { const u32x2 w = xr[64 * j]; v[rr][j][0] = ri * __builtin_bit_cast(float, w.x << 16); v[rr][j][1] = ri * __builtin_bit_cast(float, w.x & 0xffff0000u);
                    v[rr][j][2] = ri * __builtin_bit_cast(float, w.y << 16); v[rr][j][3] = ri * __builtin_bit_cast(float, w.y & 0xffff0000u); }
            }
            if (HAS_H) {
                const f32x4* spp = (const f32x4*)(SSP + (size_t)m * 16);
                const u32x2* hr = (const u32x2*)(HD + (size_t)m * DM) + lane;
#pragma unroll
                for (int j = 0; j < 4; ++j) { sp[rr][j] = spp[j]; hb[rr][j] = __builtin_nontemporal_load(hr + 64 * j); }
            }
        }
#pragma unroll
        for (int rr = 0; rr < 2; ++rr) {
            const int m = m0 + rr * NGW;
            if (HAS_H) {
                float ss = 0.f;
#pragma unroll
                for (int j = 0; j < 4; ++j) ss += (sp[rr][j][0] + sp[rr][j][1]) + (sp[rr][j][2] + sp[rr][j][3]);
                const float rh = sc * __builtin_amdgcn_rsqf(ss * (1.f / DM) + EPS);
#pragma unroll
                for (int j = 0; j < 4; ++j) {
                    const f32x4 g = ((const f32x4*)gpost)[lane + 64 * j];
                    v[rr][j][0] += bf2f((unsigned short)(hb[rr][j].x & 0xffffu)) * rh * g[0]; v[rr][j][1] += bf2f((unsigned short)(hb[rr][j].x >> 16)) * rh * g[1];
                    v[rr][j][2] += bf2f((unsigned short)(hb[rr][j].y & 0xffffu)) * rh * g[2]; v[rr][j][3] += bf2f((unsigned short)(hb[rr][j].y >> 16)) * rh * g[3];
                }
            }
            if (XOUT == 2) {
                f32x4* xo = (f32x4*)((float*)xout_ + (size_t)m * DM) + lane;
#pragma unroll
                for (int j = 0; j < 4; ++j) __builtin_nontemporal_store(v[rr][j], xo + 64 * j);
            }
            if (XOUT == 1) {
                u32x2* xo = (u32x2*)((bf16*)xout_ + (size_t)m * DM) + lane;
#pragma unroll
                for (int j = 0; j < 4; ++j) { u32x2 o; o.x = pk2(v[rr][j][0], v[rr][j][1]); o.y = pk2(v[rr][j][2], v[rr][j][3]); __builtin_nontemporal_store(o, xo + 64 * j);
                    v[rr][j][0] = __builtin_bit_cast(float, o.x << 16); v[rr][j][1] = __builtin_bit_cast(float, o.x & 0xffff0000u);
                    v[rr][j][2] = __builtin_bit_cast(float, o.y << 16); v[rr][j][3] = __builtin_bit_cast(float, o.y & 0xffff0000u); }
            }
            if (WRITE_XN) {
                float s2 = 0.f;
#pragma unroll
                for (int j = 0; j < 4; ++j) s2 += (v[rr][j][0] * v[rr][j][0] + v[rr][j][1] * v[rr][j][1]) + (v[rr][j][2] * v[rr][j][2] + v[rr][j][3] * v[rr][j][3]);
                const float ms = wave_sum(s2) * (1.f / DM) + EPS, rs = __builtin_amdgcn_rsqf(ms);
                if (lane == 0) RI[m] = ms * rs;
                u32x2* o8 = (u32x2*)(XN + (size_t)m * DM) + lane;
#pragma unroll
                for (int j = 0; j < 4; ++j) { u32x2 o; o.x = pk2(v[rr][j][0] * rs, v[rr][j][1] * rs); o.y = pk2(v[rr][j][2] * rs, v[rr][j][3] * rs); o8[64 * j] = o; }
            }
        }
    }
}

DI void compress_unit(int unit, const bf16* KV6, const bf16* CW1, const float* CBIAS, const bf16* CW2, bf16* KC, bf16* VCT, LAS unsigned char* lds, int wave, int lane, int tid) {
    const int kv = unit >> 7, bg = (unit >> 2) & 31, ct = unit & 3, r = lane & 31, h = lane >> 5;
    {
        const bf16* srcg = KV6 + (size_t)kv * KVSLAB + ((size_t)bg * 2048 + 512 * ct) * 64;
#pragma unroll
        for (int i = 0; i < 9; ++i) {
            const unsigned idx = (unsigned)tid + 512u * i;
            if (idx < 4224u) { const unsigned tk = idx >> 3, ch = idx & 7u; *(LAS u32x4*)(lds + tk * 128u + (tk >> 4) * 16u + ch * 16u) = *(const u32x4*)(srcg + idx * 8u); }
        }
    }
    __syncthreads();
    const bf16* w1 = CW1 + (size_t)kv * 256 * 2048 + ((size_t)wave * 128 * 64 + lane) * 8;
    f32x16 hacc;
#pragma unroll
    for (int i = 0; i < 16; ++i) hacc[i] = 0.f;
#pragma unroll 1
    for (int kb = 0; kb < 128; kb += 16) {
        bf16x8 a[16];
#pragma unroll
        for (int j = 0; j < 16; ++j) a[j] = *(const bf16x8*)(w1 + (size_t)(kb + j) * 512);
#pragma unroll
        for (int j = 0; j < 16; ++j) {
            const int ks = kb + j;
            const unsigned tk = 16u * r + (unsigned)(ks >> 2);
            const bf16x8 b = *(LAS const bf16x8*)(lds + tk * 128u + (tk >> 4) * 16u + (unsigned)(((ks & 3) * 16 + 8 * h) * 2));
            hacc = MFMA32(a[j], b, hacc);
        }
    }
    __syncthreads();
    const float* bias = CBIAS + kv * 256 + 32 * wave + 4 * h;
    float g[16];
#pragma unroll
    for (int a4 = 0; a4 < 4; ++a4) { const f32x4 bv = *(const f32x4*)(bias + 8 * a4);
#pragma unroll
        for (int e = 0; e < 4; ++e) { const float x = hacc[4 * a4 + e] + bv[e]; const float u2 = 2.f * 0.7978845608028654f * (x + 0.044715f * x * x * x);
            g[4 * a4 + e] = x * __builtin_amdgcn_rcpf(1.f + __builtin_amdgcn_exp2f(-1.4426950408889634f * u2)); } }
    f32x16 o2[2];
#pragma unroll
    for (int db = 0; db < 2; ++db)
#pragma unroll
        for (int i = 0; i < 16; ++i) o2[db][i] = 0.f;
    const bf16* w2 = CW2 + (size_t)kv * 64 * 256 + 32 * wave + 4 * h;
#pragma unroll
    for (int s = 0; s < 2; ++s) {
        u32x4 pb; pb.x = pk2(g[8 * s + 0], g[8 * s + 1]); pb.y = pk2(g[8 * s + 2], g[8 * s + 3]); pb.z = pk2(g[8 * s + 4], g[8 * s + 5]); pb.w = pk2(g[8 * s + 6], g[8 * s + 7]);
        const bf16x8 pbv = __builtin_bit_cast(bf16x8, pb);
#pragma unroll
        for (int db = 0; db < 2; ++db) {
            const bf16* wp = w2 + (size_t)(32 * db + r) * 256 + 16 * s;
            const s16x4 lo = *(const s16x4*)wp, hi = *(const s16x4*)(wp + 8);
            const bf16x8 af = __builtin_shufflevector(lo, hi, 0, 1, 2, 3, 4, 5, 6, 7);
            o2[db] = MFMA32(af, pbv, o2[db]);
        }
    }
    LAS float* red = (LAS float*)lds;
#pragma unroll
    for (int db = 0; db < 2; ++db)
#pragma unroll
        for (int i = 0; i < 16; ++i) red[(wave * 32 + db * 16 + i) * 64 + lane] = o2[db][i];
    __syncthreads();
    for (int e = tid; e < 2048; e += 512) {
        float s = 0.f;
#pragma unroll
        for (int w = 0; w < 8; ++w) s += red[w * 2048 + e];
        const int ln = e & 63, ri = e >> 6, db = ri >> 4, i = ri & 15, c = 32 * ct + (ln & 31), d = 32 * db + crow(i, ln >> 5);
        if (c == 127) s = 0.f;
        const unsigned short bv = pg8::cvt_bf16(s);
        if (kv == 0) KC[((size_t)bg * 128 + c) * 64 + d] = bv; else VCT[((size_t)bg * 64 + d) * 128 + c] = bv;
    }
    __syncthreads();
}

template <int MODE> DI bool key_valid(int key, int t, unsigned selmask) {
    if (MODE == 0) return key <= t;
    if (MODE == 1) return key <= t && key + 512 > t;
    if (MODE == 2) return key <= t && ((selmask >> (key >> 6)) & 1u);
    return key <= 126 && 16 * key + 31 <= t;
}
DI void load_q(bf16x8 (&qf)[4], const bf16* Qrow  ) {
#pragma unroll
    for (int ks = 0; ks < 4; ++ks) qf[ks] = *(const bf16x8*)(Qrow + 16 * ks);
}
DI f32x16 qk_tile(const bf16* Kt  , const bf16x8 (&qf)[4]) {
    f32x16 s;
#pragma unroll
    for (int i = 0; i < 16; ++i) s[i] = 0.f;
    bf16x8 kf[4];
#pragma unroll
    for (int ks = 0; ks < 4; ++ks) kf[ks] = *(const bf16x8*)(Kt + 16 * ks);
#pragma unroll
    for (int ks = 0; ks < 4; ++ks) s = MFMA32(kf[ks], qf[ks], s);
    return s;
}
template <int NDB, int MODE>
DI void attn_tile(const bf16* Kt, const bf16* Vt  , int ldv, const bf16x8 (&qf)[4], f32x16 (&o)[NDB], float& m, float& l, int key0, int t, int h, unsigned selmask) {
    f32x16 s = qk_tile(Kt, qf);
    __builtin_amdgcn_sched_barrier(0);
    float mx = -INFINITY;
#pragma unroll
    for (int i = 0; i < 16; ++i) { s[i] = key_valid<MODE>(key0 + crow(i, h), t, selmask) ? s[i] * SCL2 : -INFINITY; mx = fmaxf(mx, s[i]); }
    mx = fmaxf(mx, __shfl_xor(mx, 32));
    const float mn = fmaxf(m, mx), mu = (mn == -INFINITY) ? 0.f : mn;
    const float alpha = __builtin_amdgcn_exp2f(m - mu);
    float ps = 0.f;
#pragma unroll
    for (int i = 0; i < 16; ++i) { s[i] = __builtin_amdgcn_exp2f(s[i] - mu); ps += s[i]; }
    l = l * alpha + ps; m = mn;
#pragma unroll
    for (int db = 0; db < NDB; ++db)
#pragma unroll
        for (int i = 0; i < 16; ++i) o[db][i] *= alpha;
#pragma unroll
    for (int sI = 0; sI < 2; ++sI) {
        u32x4 pb; pb.x = pk2(s[8 * sI + 0], s[8 * sI + 1]); pb.y = pk2(s[8 * sI + 2], s[8 * sI + 3]); pb.z = pk2(s[8 * sI + 4], s[8 * sI + 5]); pb.w = pk2(s[8 * sI + 6], s[8 * sI + 7]);
        const bf16x8 pbv = __builtin_bit_cast(bf16x8, pb);
#pragma unroll
        for (int db = 0; db < NDB; ++db) {
            const bf16* vp = Vt + (size_t)(32 * db) * ldv + 16 * sI;
            const s16x4 lo = *(const s16x4*)vp, hi = *(const s16x4*)(vp + 8);
            const bf16x8 vf = __builtin_shufflevector(lo, hi, 0, 1, 2, 3, 4, 5, 6, 7);
            o[db] = MFMA32(vf, pbv, o[db]);
        }
    }
}
template <int NDB> DI void zero_o(f32x16 (&o)[NDB]) {
#pragma unroll
    for (int db = 0; db < NDB; ++db)
#pragma unroll
        for (int i = 0; i < 16; ++i) o[db][i] = 0.f;
}

DI void diff_unit(int b, int hh, int qt, float lam, const bf16* DQ, const bf16* DK, const bf16* DVT, const float* subln, bf16* AO, int lane) {
    const int r = lane & 31, h = lane >> 5, q0 = 32 * qt, t = q0 + r;
    f32x16 o0[4], o1[4];
    const bf16* Vb = DVT + (size_t)(b * 4 + hh) * 128 * 2048 + (size_t)r * 2048 + 4 * h;
#pragma unroll
    for (int mm = 0; mm < 2; ++mm) {
        const size_t slab = ((size_t)((b * 4 + hh) * 2 + mm) * 2048) * 64;
        bf16x8 qf[4]; load_q(qf, DQ + slab + (size_t)t * 64 + 8 * h);
        const bf16* Kb = DK + slab + (size_t)r * 64 + 8 * h;
        float m = -INFINITY, l = 0.f;
        zero_o<4>(o1);
        for (int kt = 0; kt <= qt; ++kt)
            attn_tile<4, 0>(Kb + (size_t)kt * 32 * 64, Vb + kt * 32, 2048, qf, o1, m, l, kt * 32, t, h, 0u);
        l += __shfl_xor(l, 32);
        const float inv = (l > 0.f) ? 1.f / l : 0.f;
        if (mm == 0) {
#pragma unroll
            for (int db = 0; db < 4; ++db)
#pragma unroll
                for (int i = 0; i < 16; ++i) o0[db][i] = o1[db][i] * inv;
        } else {
#pragma unroll
            for (int db = 0; db < 4; ++db)
#pragma unroll
                for (int i = 0; i < 16; ++i) o0[db][i] -= lam * inv * o1[db][i];
        }
    }
    float ss = 0.f;
#pragma unroll
    for (int db = 0; db < 4; ++db)
#pragma unroll
        for (int i = 0; i < 16; ++i) ss += o0[db][i] * o0[db][i];
    ss += __shfl_xor(ss, 32);
    const float rs = __builtin_amdgcn_rsqf(ss * (1.f / 128.f) + EPS) * 0.8f;
    bf16* orow = AO + (size_t)(b * 2048 + t) * 1024 + hh * 128 + 4 * h;
#pragma unroll
    for (int db = 0; db < 4; ++db)
#pragma unroll
        for (int a = 0; a < 4; ++a) {
            const f32x4 g = *(const f32x4*)(subln + 32 * db + 8 * a + 4 * h);
            u32x2 w; w.x = pk2(o0[db][4 * a + 0] * rs * g[0], o0[db][4 * a + 1] * rs * g[1]); w.y = pk2(o0[db][4 * a + 2] * rs * g[2], o0[db][4 * a + 3] * rs * g[3]);
            *(u32x2*)(orow + 32 * db + 8 * a) = w;
        }
}

DI void nsa_unit(int b, int g, int qt, const bf16* NQ, const bf16* KC, const bf16* VCT, const bf16* KV6, const float* GATES, bf16* AO, int lane) {
    const int r = lane & 31, h = lane >> 5, q0 = 32 * qt, t = q0 + r, bg = b * 2 + g;
    const bf16* KCb = KC + (size_t)bg * 128 * 64 + (size_t)r * 64 + 8 * h;
    const bf16* VCb = VCT + (size_t)bg * 64 * 128 + (size_t)r * 128 + 4 * h;
    const size_t kvoff = (size_t)bg * 2048 * 64;
    const bf16* KSb = KV6 + 2 * KVSLAB + kvoff + (size_t)r * 64 + 8 * h;
    const bf16* VSb = KV6 + 3 * KVSLAB + kvoff + (size_t)r * 2048 + 4 * h;
    const bf16* KWb = KV6 + 4 * KVSLAB + kvoff + (size_t)r * 64 + 8 * h;
    const bf16* VWb = KV6 + 5 * KVSLAB + kvoff + (size_t)r * 2048 + 4 * h;
    float imp[16];
#pragma unroll
    for (int i = 0; i < 16; ++i) imp[i] = 0.f;
#ifndef X_NOPASS1
#pragma unroll 1
    for (int hq = 0; hq < 4; ++hq) {
        bf16x8 qf[4]; load_q(qf, NQ + ((size_t)(b * 8 + g * 4 + hq) * 2048 + t) * 64 + 8 * h);
        f32x16 s[4]; float mx = -INFINITY;
#pragma unroll
        for (int T = 0; T < 4; ++T) {
            s[T] = qk_tile(KCb + (size_t)T * 32 * 64, qf);
            __builtin_amdgcn_sched_barrier(0);
#pragma unroll
            for (int i = 0; i < 16; ++i) { s[T][i] = key_valid<3>(32 * T + crow(i, h), t, 0u) ? s[T][i] : -INFINITY; mx = fmaxf(mx, s[T][i]); }
            __builtin_amdgcn_sched_barrier(0);
        }
        mx = fmaxf(mx, __shfl_xor(mx, 32));
        const float mu = (mx == -INFINITY) ? 0.f : mx;
        float ps = 0.f;
#pragma unroll
        for (int T = 0; T < 4; ++T)
#pragma unroll
            for (int i = 0; i < 16; ++i) { s[T][i] = __builtin_amdgcn_exp2f(s[T][i] - mu); ps += s[T][i]; }
        ps += __shfl_xor(ps, 32);
        const float inv = (ps > 0.f) ? 1.f / ps : 0.f;
        float xs[16];
#pragma unroll
        for (int idx = 0; idx < 16; ++idx) xs[idx] = __shfl_xor(s[idx >> 2][4 * (idx & 3) + 3], 32);
#pragma unroll
        for (int idx = 0; idx < 16; ++idx) {
            const int T = idx >> 2, a = idx & 3;
            const float w = s[T][4 * a] + s[T][4 * a + 1] + s[T][4 * a + 2] + 0.5f * s[T][4 * a + 3];
            const float cprev = (idx > 0) ? xs[idx > 0 ? idx - 1 : 0] : 0.f;
            const float carry = h ? xs[idx] : cprev;
            imp[idx] += (w + 0.5f * carry) * inv;
        }
    }
#endif
    unsigned selmask;
#ifdef X_NOTOPK
    selmask = (unsigned)imp[0];
#else
    {
        const int cur = t >> 6;
        float val[16], oth[16];
#pragma unroll
        for (int idx = 0; idx < 16; ++idx) { const int j = 2 * idx + h; const bool forced = (j == 0) || (j == cur) || (j == cur - 1);
            val[idx] = forced ? 1e9f : ((j <= cur) ? imp[idx] : -1.f); }
#pragma unroll
        for (int idx = 0; idx < 16; ++idx) oth[idx] = __shfl_xor(val[idx], 32);
        unsigned bits = 0u;
#pragma unroll
        for (int idx = 0; idx < 16; ++idx) {
            const int j = 2 * idx + h; const float v = val[idx]; int rank = 0;
#pragma unroll
            for (int i2 = 0; i2 < 16; ++i2) {
                const int j2 = 2 * i2 + h, j3 = 2 * i2 + 1 - h;
                rank += (val[i2] > v || (val[i2] == v && j2 < j)) ? 1 : 0;
                rank += (oth[i2] > v || (oth[i2] == v && j3 < j)) ? 1 : 0;
                asm volatile("" : "+v"(rank));
            }
            bits |= (rank < 16) ? (1u << j) : 0u;
        }
        selmask = bits | (unsigned)__shfl_xor((int)bits, 32);
    }
#endif
#pragma unroll 1
    for (int hq = 0; hq < 4; ++hq) {
        const int head = g * 4 + hq;
        bf16x8 qf[4]; load_q(qf, NQ + ((size_t)(b * 8 + head) * 2048 + t) * 64 + 8 * h);
        const float* gp = GATES + (size_t)(b * 2048 + t) * 24 + head * 3;
        const float g0 = gp[0], g1 = gp[1], g2 = gp[2];
        f32x16 out[2], o[2];
        zero_o<2>(out);
#ifndef X_NOCMP
        {
            float m = -INFINITY, l = 0.f; zero_o<2>(o);
#pragma unroll 1
            for (int T = 0; T < 4; ++T) attn_tile<2, 3>(KCb + (size_t)T * 32 * 64, VCb + T * 32, 128, qf, o, m, l, T * 32, t, h, 0u);
            l += __shfl_xor(l, 32); const float f = (l > 0.f) ? g0 / l : 0.f;
#pragma unroll
            for (int db = 0; db < 2; ++db)
#pragma unroll
                for (int i = 0; i < 16; ++i) out[db][i] += f * o[db][i];
        }
#endif
#ifndef X_NOSEL
        {
            float m = -INFINITY, l = 0.f; zero_o<2>(o);
#pragma unroll 1
            for (int kt = 0; kt <= qt; ++kt) {
                if (!__any((int)((selmask >> (kt >> 1)) & 1u))) continue;
                attn_tile<2, 2>(KSb + (size_t)kt * 32 * 64, VSb + kt * 32, 2048, qf, o, m, l, kt * 32, t, h, selmask);
            }
            l += __shfl_xor(l, 32); const float f = (l > 0.f) ? g1 / l : 0.f;
#pragma unroll
            for (int db = 0; db < 2; ++db)
#pragma unroll
                for (int i = 0; i < 16; ++i) out[db][i] += f * o[db][i];
        }
#endif
#ifndef X_NOWIN
        {
            float m = -INFINITY, l = 0.f; zero_o<2>(o);
            const int klo = (qt > 16) ? qt - 16 : 0;
#pragma unroll 1
            for (int kt = klo; kt <= qt; ++kt) attn_tile<2, 1>(KWb + (size_t)kt * 32 * 64, VWb + kt * 32, 2048, qf, o, m, l, kt * 32, t, h, 0u);
            l += __shfl_xor(l, 32); const float f = (l > 0.f) ? g2 / l : 0.f;
#pragma unroll
            for (int db = 0; db < 2; ++db)
#pragma unroll
                for (int i = 0; i < 16; ++i) out[db][i] += f * o[db][i];
        }
#endif
        bf16* orow = AO + (size_t)(b * 2048 + t) * 1024 + 512 + head * 64 + 4 * h;
#pragma unroll
        for (int db = 0; db < 2; ++db)
#pragma unroll
            for (int a = 0; a < 4; ++a) {
                u32x2 w; w.x = pk2(out[db][4 * a + 0], out[db][4 * a + 1]); w.y = pk2(out[db][4 * a + 2], out[db][4 * a + 3]);
                *(u32x2*)(orow + 32 * db + 8 * a) = w;
            }
    }
}


constexpr int KSTR = 72, VSTR = 68;
constexpr int KBUF_B = 64 * KSTR * 2, VBUF_B = 128 * VSTR * 2, ABUF_B = KBUF_B + VBUF_B;
constexpr int NBUF_B = KBUF_B + 64 * VSTR * 2;
constexpr int A_IMPX = 73728, A_MISC = A_IMPX + 8 * 16 * 64 * 4;
static_assert(4 * NBUF_B <= A_IMPX && 2 * ABUF_B <= A_IMPX && A_MISC + 256 <= 131072, "attention LDS map");
template <int NV> struct Stage { u32x4 k; u32x4 v[NV]; };
template <int NV> DI void stage_load(Stage<NV>& st, const bf16* Kg, const bf16* Vg, int ldv, int tid) {
    const unsigned ut = (unsigned)tid;
    st.k = *(const u32x4*)(Kg + ((ut >> 3) * 64u + (ut & 7u) * 8u));
#pragma unroll
    for (int i = 0; i < NV; ++i) { const unsigned idx = ut + 512u * i; st.v[i] = *(const u32x4*)(Vg + ((idx >> 3) * (unsigned)ldv + (idx & 7u) * 8u)); }
}
template <int NV> DI void stage_store(const Stage<NV>& st, LAS unsigned char* buf, int tid) {
    *(LAS u32x4*)(buf + ((tid >> 3) * KSTR + (tid & 7) * 8) * 2) = st.k;
#pragma unroll
    for (int i = 0; i < NV; ++i) { const int idx = tid + 512 * i; LAS unsigned char* q = buf + KBUF_B + ((idx >> 3) * VSTR + (idx & 7) * 8) * 2;
        u32x2 a; a.x = st.v[i].x; a.y = st.v[i].y; u32x2 b; b.x = st.v[i].z; b.y = st.v[i].w;
        *(LAS u32x2*)q = a; *(LAS u32x2*)(q + 8) = b; }
}
template <int NDB, int MODE, bool MASKED>
DI void tile_compute(LAS const unsigned char* buf, const bf16x8 (&qf)[4], f32x16 (&o)[NDB], float& m, float& l, int key0, int t, int r, int h, unsigned selmask) {
#pragma unroll
    for (int sub = 0; sub < 2; ++sub) {
        f32x16 s;
#pragma unroll
        for (int i = 0; i < 16; ++i) s[i] = 0.f;
        bf16x8 kf[4];
        LAS const unsigned char* kp = buf + ((sub * 32 + r) * KSTR + 8 * h) * 2;
#pragma unroll
        for (int ks = 0; ks < 4; ++ks) kf[ks] = *(LAS const bf16x8*)(kp + 32 * ks);
#pragma unroll
        for (int ks = 0; ks < 4; ++ks) s = MFMA32(kf[ks], qf[ks], s);
        __builtin_amdgcn_sched_barrier(0);
        float mx = -INFINITY;
        if (MASKED) {
#pragma unroll
            for (int i = 0; i < 16; ++i) { s[i] = key_valid<MODE>(key0 + 32 * sub + crow(i, h), t, selmask) ? s[i] : -INFINITY; mx = fmaxf(mx, s[i]); }
        } else {
#pragma unroll
            for (int i = 0; i < 16; ++i) mx = fmaxf(mx, s[i]);
        }
        mx = fmaxf(mx, __shfl_xor(mx, 32));
        const bool need = mx > m + 8.f;
        if (__any((int)need)) {
            const float mn = need ? mx : m;
            const float alpha = need ? __builtin_amdgcn_exp2f(m - mn) : 1.f;
            l *= alpha; m = mn;
#pragma unroll
            for (int db = 0; db < NDB; ++db)
#pragma unroll
                for (int i = 0; i < 16; ++i) o[db][i] *= alpha;
        }
        const float mu = (m == -INFINITY) ? 0.f : m;
        float ps = 0.f;
#pragma unroll
        for (int i = 0; i < 16; ++i) { s[i] = __builtin_amdgcn_exp2f(s[i] - mu); ps += s[i]; }
        l += ps;
#pragma unroll
        for (int sI = 0; sI < 2; ++sI) {
            u32x4 pb; pb.x = pk2(s[8 * sI + 0], s[8 * sI + 1]); pb.y = pk2(s[8 * sI + 2], s[8 * sI + 3]); pb.z = pk2(s[8 * sI + 4], s[8 * sI + 5]); pb.w = pk2(s[8 * sI + 6], s[8 * sI + 7]);
            const bf16x8 pbv = __builtin_bit_cast(bf16x8, pb);
#pragma unroll
            for (int db = 0; db < NDB; ++db) {
                LAS const unsigned char* vp = buf + KBUF_B + ((32 * db + r) * VSTR + 32 * sub + 16 * sI + 4 * h) * 2;
                const s16x4 lo = *(LAS const s16x4*)vp, hi = *(LAS const s16x4*)(vp + 16);
                const bf16x8 vf = __builtin_shufflevector(lo, hi, 0, 1, 2, 3, 4, 5, 6, 7);
                o[db] = MFMA32(vf, pbv, o[db]);
            }
        }
    }
}
template <int NDB, int MODE>
DI void flash_block(const bf16* Kg, const bf16* Vg, int ldv, unsigned tiles, LAS unsigned char* lds, const bf16x8 (&qf)[4], f32x16 (&o)[NDB], float& m, float& l,
                    int t, int qlo, int r, int h, unsigned selmask, int tid) {
    Stage<NDB / 2> st;
    unsigned rem = tiles; int cur = -1, bufi = 0;
    if (rem) { cur = __builtin_ctz(rem); rem &= rem - 1u; stage_load(st, Kg + (size_t)cur * 64 * 64, Vg + cur * 64, ldv, tid); }
    __syncthreads();
    while (cur >= 0) {
        LAS unsigned char* buf = lds + bufi * ABUF_B;
        stage_store(st, buf, tid);
        int nxt = -1;
        if (rem) { nxt = __builtin_ctz(rem); rem &= rem - 1u; stage_load(st, Kg + (size_t)nxt * 64 * 64, Vg + nxt * 64, ldv, tid); }
        __syncthreads();
        const int key0 = cur * 64;
        bool rel = true, msk = true;
        if (MODE == 0) { rel = key0 <= qlo + 31; msk = key0 + 63 > qlo; }
        if (MODE == 1) { rel = key0 <= qlo + 31 && key0 + 63 + 512 > qlo; msk = (key0 + 63 > qlo) || (key0 + 512 <= qlo + 31); }
        if (MODE == 2) { const int bit = (int)((selmask >> cur) & 1u); rel = key0 <= qlo + 31 && __any(bit); msk = (key0 + 63 > qlo) || !__all(bit); }
        if (rel) {
            if (msk) tile_compute<NDB, MODE, true>(buf, qf, o, m, l, key0, t, r, h, selmask);
            else tile_compute<NDB, MODE, false>(buf, qf, o, m, l, key0, t, r, h, selmask);
        }
        cur = nxt; bufi ^= 1;
    }
}

template <int MODE>
DI void flash_block2(const bf16* Kg, const bf16* Vg, int ldv, unsigned tiles, LAS unsigned char* lds, const bf16x8 (&qf)[4], f32x16 (&o)[2], float& m, float& l,
                     int t, int qlo, int r, int h, unsigned selmask, int tid) {
    Stage<1> st0, st1;
    unsigned rem = tiles; int c0 = -1, c1 = -1, bufi = 0;
    if (rem) { c0 = __builtin_ctz(rem); rem &= rem - 1u; stage_load(st0, Kg + (size_t)c0 * 64 * 64, Vg + c0 * 64, ldv, tid); }
    if (rem) { c1 = __builtin_ctz(rem); rem &= rem - 1u; stage_load(st1, Kg + (size_t)c1 * 64 * 64, Vg + c1 * 64, ldv, tid); }
    __syncthreads();
    while (c0 >= 0) {
        LAS unsigned char* bufa = lds + (2 * bufi) * NBUF_B;
        LAS unsigned char* bufb = bufa + NBUF_B;
        stage_store(st0, bufa, tid);
        if (c1 >= 0) stage_store(st1, bufb, tid);
        int n0 = -1, n1 = -1;
        if (rem) { n0 = __builtin_ctz(rem); rem &= rem - 1u; stage_load(st0, Kg + (size_t)n0 * 64 * 64, Vg + n0 * 64, ldv, tid); }
        if (rem) { n1 = __builtin_ctz(rem); rem &= rem - 1u; stage_load(st1, Kg + (size_t)n1 * 64 * 64, Vg + n1 * 64, ldv, tid); }
        __syncthreads();
#pragma unroll
        for (int half = 0; half < 2; ++half) {
            const int cur = half ? c1 : c0;
            if (cur < 0) continue;
            LAS unsigned char* buf = half ? bufb : bufa;
            const int key0 = cur * 64;
            bool rel = true, msk = true;
            if (MODE == 1) { rel = key0 <= qlo + 31 && key0 + 63 + 512 > qlo; msk = (key0 + 63 > qlo) || (key0 + 512 <= qlo + 31); }
            if (MODE == 2) { const int bit = (int)((selmask >> cur) & 1u); rel = key0 <= qlo + 31 && __any(bit); msk = (key0 + 63 > qlo) || !__all(bit); }
            if (rel) {
                if (msk) tile_compute<2, MODE, true>(buf, qf, o, m, l, key0, t, r, h, selmask);
                else tile_compute<2, MODE, false>(buf, qf, o, m, l, key0, t, r, h, selmask);
            }
        }
        c0 = n0; c1 = n1; bufi ^= 1;
    }
}

DI void diff_block(int b, int hh, int qb, float lam, const bf16* DQ, const bf16* DK, const bf16* DVT, const float* subln, bf16* AO, LAS unsigned char* lds, int wave, int lane, int tid) {
    const int r = lane & 31, h = lane >> 5, qlo = 256 * qb + 32 * wave, t = qlo + r;
    f32x16 o1[4];
    const bf16* Vg = DVT + (size_t)(b * 4 + hh) * 128 * 2048;
    const int ntile = 4 * qb + 4; const unsigned tiles = (ntile >= 32) ? 0xffffffffu : ((1u << ntile) - 1u);
    bf16* orow = AO + (size_t)(b * 2048 + t) * 1024 + hh * 128 + 4 * h;
    float ss = 0.f;
#pragma unroll 1
    for (int mm = 0; mm < 2; ++mm) {
        const size_t slab = ((size_t)((b * 4 + hh) * 2 + mm) * 2048) * 64;
        bf16x8 qf[4]; load_q(qf, DQ + slab + (size_t)t * 64 + 8 * h);
        float m = -INFINITY, l = 0.f;
        zero_o<4>(o1);
        flash_block<4, 0>(DK + slab, Vg, 2048, tiles, lds, qf, o1, m, l, t, qlo, r, h, 0u, tid);
        l += __shfl_xor(l, 32);
        const float inv = (l > 0.f) ? 1.f / l : 0.f;
        if (mm == 0) {
#pragma unroll
            for (int db = 0; db < 4; ++db)
#pragma unroll
                for (int a = 0; a < 4; ++a) {
                    u32x2 w; w.x = pk2(o1[db][4 * a + 0] * inv, o1[db][4 * a + 1] * inv); w.y = pk2(o1[db][4 * a + 2] * inv, o1[db][4 * a + 3] * inv);
                    *(u32x2*)(orow + 32 * db + 8 * a) = w;
                }
        } else {
            const float li = lam * inv;
#pragma unroll
            for (int db = 0; db < 4; ++db)
#pragma unroll
                for (int a = 0; a < 4; ++a) {
                    const u32x2 w = *(const u32x2*)(orow + 32 * db + 8 * a);
                    o1[db][4 * a + 0] = __builtin_bit_cast(float, w.x << 16) - li * o1[db][4 * a + 0];
                    o1[db][4 * a + 1] = __builtin_bit_cast(float, w.x & 0xffff0000u) - li * o1[db][4 * a + 1];
                    o1[db][4 * a + 2] = __builtin_bit_cast(float, w.y << 16) - li * o1[db][4 * a + 2];
                    o1[db][4 * a + 3] = __builtin_bit_cast(float, w.y & 0xffff0000u) - li * o1[db][4 * a + 3];
                    ss += (o1[db][4 * a + 0] * o1[db][4 * a + 0] + o1[db][4 * a + 1] * o1[db][4 * a + 1]) + (o1[db][4 * a + 2] * o1[db][4 * a + 2] + o1[db][4 * a + 3] * o1[db][4 * a + 3]);
                }
        }
    }
    ss += __shfl_xor(ss, 32);
    const float rs = __builtin_amdgcn_rsqf(ss * (1.f / 128.f) + EPS) * 0.8f;
#pragma unroll
    for (int db = 0; db < 4; ++db)
#pragma unroll
        for (int a = 0; a < 4; ++a) {
            const f32x4 g = *(const f32x4*)(subln + 32 * db + 8 * a + 4 * h);
            u32x2 w; w.x = pk2(o1[db][4 * a + 0] * rs * g[0], o1[db][4 * a + 1] * rs * g[1]); w.y = pk2(o1[db][4 * a + 2] * rs * g[2], o1[db][4 * a + 3] * rs * g[3]);
            *(u32x2*)(orow + 32 * db + 8 * a) = w;
        }
}

DI void nsa_block(int b, int g, int c, const bf16* NQ, const bf16* KC, const bf16* VCT, const bf16* KV6, const float* GATES, bf16* AO, LAS unsigned char* lds, int wave, int lane, int tid) {
    const int r = lane & 31, h = lane >> 5, hq = wave >> 1, qs = wave & 1, qlo = 64 * c + 32 * qs, t = qlo + r, bg = b * 2 + g, head = g * 4 + hq;
    const bf16* KCg = KC + (size_t)bg * 128 * 64;
    const bf16* VCg = VCT + (size_t)bg * 64 * 128;
    const size_t kvoff = (size_t)bg * 2048 * 64;
    bf16x8 qf[4]; load_q(qf, NQ + ((size_t)(b * 8 + head) * 2048 + t) * 64 + 8 * h);
    unsigned selmask, uni;
    const unsigned causal = (c >= 31) ? 0xffffffffu : ((2u << c) - 1u);
    if (c >= 16) {
    float imp[16];
    {
        const bf16* KCb = KCg + (size_t)r * 64 + 8 * h;
        f32x16 s[4]; float mx = -INFINITY;
#pragma unroll
        for (int T = 0; T < 4; ++T) {
            s[T] = qk_tile(KCb + (size_t)T * 32 * 64, qf);
            __builtin_amdgcn_sched_barrier(0);
#pragma unroll
            for (int i = 0; i < 16; ++i) { s[T][i] = key_valid<3>(32 * T + crow(i, h), t, 0u) ? s[T][i] : -INFINITY; mx = fmaxf(mx, s[T][i]); }
            __builtin_amdgcn_sched_barrier(0);
        }
        mx = fmaxf(mx, __shfl_xor(mx, 32));
        const float mu = (mx == -INFINITY) ? 0.f : mx;
        float ps = 0.f;
#pragma unroll
        for (int T = 0; T < 4; ++T)
#pragma unroll
            for (int i = 0; i < 16; ++i) { s[T][i] = __builtin_amdgcn_exp2f(s[T][i] - mu); ps += s[T][i]; }
        ps += __shfl_xor(ps, 32);
        const float inv = (ps > 0.f) ? 1.f / ps : 0.f;
        float xs[16];
#pragma unroll
        for (int idx = 0; idx < 16; ++idx) xs[idx] = __shfl_xor(s[idx >> 2][4 * (idx & 3) + 3], 32);
#pragma unroll
        for (int idx = 0; idx < 16; ++idx) {
            const int T = idx >> 2, a = idx & 3;
            const float w = s[T][4 * a] + s[T][4 * a + 1] + s[T][4 * a + 2] + 0.5f * s[T][4 * a + 3];
            const float cprev = (idx > 0) ? xs[idx > 0 ? idx - 1 : 0] : 0.f;
            const float carry = h ? xs[idx] : cprev;
            imp[idx] = (w + 0.5f * carry) * inv;
        }
    }
    LAS float* impx = (LAS float*)(lds + A_IMPX);
    LAS unsigned* misc = (LAS unsigned*)(lds + A_MISC);
#pragma unroll
    for (int idx = 0; idx < 16; ++idx) impx[(wave * 16 + idx) * 64 + lane] = imp[idx];
    if (tid == 0) misc[8] = 0u;
    __syncthreads();
#pragma unroll
    for (int idx = 0; idx < 16; ++idx) imp[idx] = (impx[((0 * 2 + qs) * 16 + idx) * 64 + lane] + impx[((1 * 2 + qs) * 16 + idx) * 64 + lane]) + (impx[((2 * 2 + qs) * 16 + idx) * 64 + lane] + impx[((3 * 2 + qs) * 16 + idx) * 64 + lane]);
    {
        const int cur = t >> 6;
        float val[16], oth[16];
#pragma unroll
        for (int idx = 0; idx < 16; ++idx) { const int j = 2 * idx + h; const bool forced = (j == 0) || (j == cur) || (j == cur - 1);
            val[idx] = forced ? 1e9f : ((j <= cur) ? imp[idx] : -1.f); }
#pragma unroll
        for (int idx = 0; idx < 16; ++idx) oth[idx] = __shfl_xor(val[idx], 32);
        unsigned bits = 0u;
#pragma unroll
        for (int idx = 0; idx < 16; ++idx) {
            const int j = 2 * idx + h; const float v = val[idx]; int rank = 0;
#pragma unroll
            for (int i2 = 0; i2 < 16; ++i2) {
                const int j2 = 2 * i2 + h, j3 = 2 * i2 + 1 - h;
                rank += (val[i2] > v || (val[i2] == v && j2 < j)) ? 1 : 0;
                rank += (oth[i2] > v || (oth[i2] == v && j3 < j)) ? 1 : 0;
                asm volatile("" : "+v"(rank));
            }
            bits |= (rank < 16) ? (1u << j) : 0u;
        }
        selmask = bits | (unsigned)__shfl_xor((int)bits, 32);
    }
    __hip_atomic_fetch_or((LAS unsigned*)&misc[8], selmask, __ATOMIC_RELAXED, __HIP_MEMORY_SCOPE_WORKGROUP);
    __syncthreads();
    uni = misc[8];
    uni = (unsigned)__builtin_amdgcn_readfirstlane((int)uni);
    } else { selmask = causal; uni = causal; }
    const float* gp = GATES + (size_t)(b * 2048 + t) * 24 + head * 3;
    const float g0 = gp[0], g1 = gp[1], g2 = gp[2];
    f32x16 out[2], o[2];
    zero_o<2>(out);
    {
        float m = -INFINITY, l = 0.f; zero_o<2>(o);
        flash_block2<3>(KCg, VCg, 128, 3u, lds, qf, o, m, l, t, qlo, r, h, 0u, tid);
        l += __shfl_xor(l, 32); const float f = (l > 0.f) ? g0 / l : 0.f;
#pragma unroll
        for (int db = 0; db < 2; ++db)
#pragma unroll
            for (int i = 0; i < 16; ++i) out[db][i] += f * o[db][i];
    }
    {
        float m = -INFINITY, l = 0.f; zero_o<2>(o);
        flash_block2<2>(KV6 + 2 * KVSLAB + kvoff, KV6 + 3 * KVSLAB + kvoff, 2048, uni & causal, lds, qf, o, m, l, t, qlo, r, h, selmask, tid);
        l += __shfl_xor(l, 32); const float f = (l > 0.f) ? g1 / l : 0.f;
#pragma unroll
        for (int db = 0; db < 2; ++db)
#pragma unroll
            for (int i = 0; i < 16; ++i) out[db][i] += f * o[db][i];
    }
    {
        float m = -INFINITY, l = 0.f; zero_o<2>(o);
        const unsigned lowm = (c > 8) ? ((1u << (c - 8)) - 1u) : 0u;
        flash_block2<1>(KV6 + 4 * KVSLAB + kvoff, KV6 + 5 * KVSLAB + kvoff, 2048, causal & ~lowm, lds, qf, o, m, l, t, qlo, r, h, 0u, tid);
        l += __shfl_xor(l, 32); const float f = (l > 0.f) ? g2 / l : 0.f;
#pragma unroll
        for (int db = 0; db < 2; ++db)
#pragma unroll
            for (int i = 0; i < 16; ++i) out[db][i] += f * o[db][i];
    }
    bf16* orow = AO + (size_t)(b * 2048 + t) * 1024 + 512 + head * 64 + 4 * h;
#pragma unroll
    for (int db = 0; db < 2; ++db)
#pragma unroll
        for (int a = 0; a < 4; ++a) {
            u32x2 w; w.x = pk2(out[db][4 * a + 0], out[db][4 * a + 1]); w.y = pk2(out[db][4 * a + 2], out[db][4 * a + 3]);
            *(u32x2*)(orow + 32 * db + 8 * a) = w;
        }
}

__global__ void __launch_bounds__(512) mega(Params p) {
    extern __shared__ __attribute__((aligned(16))) unsigned char lds_raw[];
    cg::grid_group grid = cg::this_grid();
    LAS unsigned char* lds = (LAS unsigned char*)lds_raw;
#define FRESH_IDS() int tid = threadIdx.x; asm volatile("" : "+v"(tid)); const int lane = tid & 63, wave = __builtin_amdgcn_readfirstlane(tid >> 6); const int gw = blockIdx.x * 8 + wave; (void)gw; (void)lane; (void)wave;
    const int G = gridDim.x, NGW = G * 8;
    unsigned char* ws = p.ws;
    unsigned* ctl = (unsigned*)(ws + WS_CTL);
    float* ROPE = (float*)(ws + WS_ROPE); float* CBIAS = (float*)(ws + WS_CBIAS); bf16* CW2 = (bf16*)(ws + WS_CW2); bf16* KC = (bf16*)(ws + WS_KC); bf16* VCT = (bf16*)(ws + WS_VCT);
    bf16* CW1 = (bf16*)(ws + WS_CW1); float* SSP = (float*)(ws + WS_SSP); float* GATES = (float*)(ws + WS_GATES);
    bf16* WOUT = (bf16*)(ws + WS_WOUT); bf16* WIN = (bf16*)(ws + WS_WIN); bf16* WGU1 = (bf16*)(ws + WS_WGU1); bf16* WD1 = (bf16*)(ws + WS_WD1); bf16* WGU2 = (bf16*)(ws + WS_WGU2); bf16* WD2 = (bf16*)(ws + WS_WD2);
    bf16* XR = (bf16*)(ws + WS_XR);
    float* RI = (float*)(ws + (52u << 20));
    bf16* XN = (bf16*)(ws + WS_XN); bf16* HD = (bf16*)(ws + WS_HD); bf16* HB = (bf16*)(ws + WS_HB);
    bf16* DQ = (bf16*)(ws + WS_DQ); bf16* DK = (bf16*)(ws + WS_DK); bf16* DVT = (bf16*)(ws + WS_DVT); bf16* NQ = (bf16*)(ws + WS_NQ); bf16* KV6 = (bf16*)(ws + WS_KV6);
    const float* x = p.in[0]; float* out = p.out;

    if (threadIdx.x < 64) ((LAS unsigned*)(lds + 131072))[threadIdx.x] = 0u;
    __syncthreads();
    XcdBarrier xbar = xcd_barrier_post((unsigned*)(ws + WS_BAR), (volatile LAS unsigned*)(lds + 131072));
#define GRID_SYNC() xcd_barrier(xbar)
    if (p.out == nullptr) grid.sync();
    {
        FRESH_IDS();
        if (blockIdx.x == 0 && tid < 64) ctl[tid] = 0u;
        LAS float* scr = (LAS float*)(lds + wave * 8448);
        constexpr int I_GU = 16 * 88, I_DN = 44 * 32, I_IN = 16 * 96, I_OUT = 16 * 32, I_C1 = 32 * 8, I_C2 = 4 * 2;
        constexpr int NITEMS = 4 * I_GU + 2 * I_DN + I_IN + I_OUT + 2 * I_C1 + 2 * I_C2;
        for (int it = gw; it < NITEMS; it += NGW) {
            int q = it;
            if (q < 4 * I_GU) {
                const int which = q / I_GU; q -= which * I_GU; const int kb = q / 88, nb = q % 88, n0 = 32 * nb;
                const float* W = p.in[which == 0 ? 2 : which == 1 ? 3 : which == 2 ? 22 : 23];
                bf16* dst = (which < 2) ? WGU1 : WGU2;
                transpose_item(W, 1024, FF, dst, 256 * (n0 >> 7) + (n0 & 127) + ((which & 1) ? 128 : 0), scr, 64 * kb, n0, lane, p.in[which < 2 ? 1 : 21]);
                continue;
            }
            q -= 4 * I_GU;
            if (q < 2 * I_DN) { const int which = q / I_DN; q -= which * I_DN; const int kb = q / 32, nb = q % 32;
                transpose_item(p.in[which ? 24 : 4], FF, 1024, which ? WD2 : WD1, 32 * nb, scr, 64 * kb, 32 * nb, lane); continue; }
            q -= 2 * I_DN;
            if (q < I_IN) { const int kb = q / 96, nb = q % 96; transpose_item(p.in[7], 1024, NIN, WIN, 32 * nb, scr, 64 * kb, 32 * nb, lane, p.in[6]); continue; }
            q -= I_IN;
            if (q < I_OUT) { const int kb = q / 32, nb = q % 32; transpose_item(p.in[19], 1024, 1024, WOUT, 32 * nb, scr, 64 * kb, 32 * nb, lane); continue; }
            q -= I_OUT;
            if (q < 2 * I_C1) { const int which = q / I_C1; q -= which * I_C1; const int kb = q / 8, nb = q % 8;
                transpose_item<true>(p.in[which ? 17 : 14], 2048, 256, CW1 + (size_t)which * 256 * 2048, 32 * nb, scr, 64 * kb, 32 * nb, lane); continue; }
            q -= 2 * I_C1;
            { const int which = q / I_C2; q -= which * I_C2; const int kb = q / 2, nb = q % 2;
              transpose_item(p.in[which ? 18 : 15], 256, 64, CW2 + (size_t)which * 64 * 256, 32 * nb, scr, 64 * kb, 32 * nb, lane); }
        }
        for (int i = blockIdx.x * 512 + tid; i < 2048 * 8; i += G * 512) {
            const int tt = i >> 3, e = i & 7;
            const double inv = exp2(-(double)e * (18.931568569324174 / 8.0));
            const double xr = (double)tt * inv * 0.15915494309189535;
            const double fr = xr - rint(xr);
            const float ang = (float)(fr * 6.283185307179586);
            ROPE[tt * 16 + e] = cosf(ang); ROPE[tt * 16 + 8 + e] = sinf(ang);
        }
        if ((int)blockIdx.x >= G - 16) {
            const int j = (G - 1) - (int)blockIdx.x, kv = j >> 3, sl = (j & 7) * 8 + wave;
            const float* pe = p.in[kv ? 16 : 13] + sl * 32; const float* w1 = p.in[kv ? 17 : 14] + (size_t)sl * 32 * 256;
            f32x4 a = {0.f, 0.f, 0.f, 0.f};
#pragma unroll
            for (int k = 0; k < 32; ++k) { const float pv = pe[k]; const f32x4 w = ((const f32x4*)(w1 + (size_t)k * 256))[lane]; a += pv * w; }
            ((f32x4*)(CBIAS + 1024 + (size_t)(kv * 64 + sl) * 256))[lane] = a;
        }
        rows_phase<false, 0, 0, true>(x, nullptr, nullptr, nullptr, 0.f, nullptr, nullptr, XN, RI, gw, NGW, lane);
    }
    GRID_SYNC();

#ifndef ONLY_ATT
#ifdef PROBE_SYNC
    for (int rep = 0; rep < 10; ++rep) GRID_SYNC();
#endif
#ifdef PROBE_P1
    for (int rep = 0; rep < 2; ++rep)
#endif
    { pg8::Gemm g{XN, WGU1, MROWS, NGU, DM}; pg8::StaticOrder S; S.init(MROWS, NGU, G, (int)blockIdx.x); pg8::EpiSwiglu E{HB, FF};
      pg8::gemm_phase<pg8::EpiSwiglu, pg8::StaticOrder, PG8_ALIGN_SW, true>(lds, g, S, E); }
    GRID_SYNC();
#ifdef PROBE_P2
    for (int rep = 0; rep < 2; ++rep)
#endif
    { pg8::Gemm g{HB, WD1, MROWS, DM, FF}; pg8::StaticOrder S; S.init(MROWS, DM, G, (int)blockIdx.x); pg8::EpiStoreSS E{HD, SSP};
      pg8::gemm_phase<pg8::EpiStoreSS, pg8::StaticOrder, true, true>(lds, g, S, E); }
    GRID_SYNC();
#ifdef PROBE_P3
    for (int rep = 0; rep < 2; ++rep)
#endif
    { FRESH_IDS();
      if (blockIdx.x == 0) { float s = 0.f; const float* pp = CBIAS + 1024 + (size_t)((tid >> 8) * 64) * 256 + (tid & 255);
#pragma unroll 16
          for (int q = 0; q < 64; ++q) s += pp[q * 256];
          CBIAS[tid] = s; }
      rows_phase<true, 1, 0, true>(XN, HD, SSP, p.in[5], 0.5f, nullptr, nullptr, XN, RI, gw, NGW, lane); }
    GRID_SYNC();
#ifdef PROBE_P4
    for (int rep = 0; rep < 2; ++rep)
#endif
    { pg8::Gemm g{XN, WIN, MROWS, NINP, DM}; pg8::StaticOrder S; S.init(MROWS, NINP, G, (int)blockIdx.x); pg8::EpiWin E{DQ, DK, DVT, NQ, KV6, GATES, ROPE};
      pg8::gemm_phase<pg8::EpiWin, pg8::StaticOrder, true, true>(lds, g, S, E); }
    GRID_SYNC();
#ifndef SKIP_CMP
#ifdef PROBE_P5
    for (int rep = 0; rep < 2; ++rep)
#endif
    { FRESH_IDS(); for (int u = blockIdx.x; u < 256; u += G) compress_unit(u, KV6, CW1, CBIAS, CW2, KC, VCT, lds, wave, lane, tid); }
#endif
    GRID_SYNC();
#endif
    {
        FRESH_IDS();
        float lam;
        { const float a = p.in[8][lane] * p.in[9][lane], c = p.in[10][lane] * p.in[11][lane];
          lam = __expf(wave_sum(a)) - __expf(wave_sum(c)) + 0.2f; }
        LAS unsigned* misc = (LAS unsigned*)(lds + A_MISC);
#ifdef PROBE_P6
        for (int rep = 0; rep < 2; ++rep)
#else
        const int rep = 0;
#endif
        {
#ifndef SKIP_DIFF
        for (;;) {
            __syncthreads();
            if (tid == 0) misc[0] = atomicAdd(ctl + 8 * rep, 1u);
            __syncthreads();
            const int u = __builtin_amdgcn_readfirstlane((int)misc[0]);
            if (u >= 512) break;
            int tidu = tid; asm volatile("" : "+v"(tidu));
            const int laneu = tidu & 63, waveu = __builtin_amdgcn_readfirstlane(tidu >> 6);
            const int idx = u & 63;
            diff_block(idx >> 2, idx & 3, 7 - (u >> 6), lam, DQ, DK, DVT, p.in[12], XR, lds, waveu, laneu, tidu);
        }
#endif
#ifndef SKIP_NSA
        for (;;) {
            __syncthreads();
            if (tid == 0) misc[0] = atomicAdd(ctl + 8 * rep + 4, 1u);
            __syncthreads();
            const int u = __builtin_amdgcn_readfirstlane((int)misc[0]);
            if (u >= 1024) break;
            int tidu = tid; asm volatile("" : "+v"(tidu));
            const int laneu = tidu & 63, waveu = __builtin_amdgcn_readfirstlane(tidu >> 6);
            const int idx = u & 31;
            nsa_block(idx >> 1, idx & 1, 31 - (u >> 5), NQ, KC, VCT, KV6, GATES, XR, lds, waveu, laneu, tidu);
        }
#endif
        }
    }
    GRID_SYNC();
#ifndef ONLY_ATT
    { pg8::Gemm g{XR, WOUT, MROWS, DM, DM}; pg8::StaticOrder S; S.init(MROWS, DM, G, (int)blockIdx.x); pg8::EpiStoreSS E{HD, SSP};
      pg8::gemm_phase<pg8::EpiStoreSS, pg8::StaticOrder, true, true>(lds, g, S, E); }
    GRID_SYNC();
    { FRESH_IDS(); rows_phase<true, 1, 0, true>(XN, HD, SSP, p.in[20], 1.0f, nullptr, nullptr, XN, RI, gw, NGW, lane); }
    GRID_SYNC();
    { pg8::Gemm g{XN, WGU2, MROWS, NGU, DM}; pg8::StaticOrder S; S.init(MROWS, NGU, G, (int)blockIdx.x); pg8::EpiSwiglu E{HB, FF};
      pg8::gemm_phase<pg8::EpiSwiglu, pg8::StaticOrder, PG8_ALIGN_SW, true>(lds, g, S, E); }
    GRID_SYNC();
    { pg8::Gemm g{HB, WD2, MROWS, DM, FF}; pg8::StaticOrder S; S.init(MROWS, DM, G, (int)blockIdx.x); pg8::EpiStoreSS E{HD, SSP};
      pg8::gemm_phase<pg8::EpiStoreSS, pg8::StaticOrder, true, true>(lds, g, S, E); }
    GRID_SYNC();
    { FRESH_IDS(); rows_phase<true, 1, 2, false>(XN, HD, SSP, p.in[25], 0.5f, out, nullptr, nullptr, RI, gw, NGW, lane); }
#endif
}

extern "C" void kernel_launch(void* const* d_in, const int* in_sizes, int n_in, void* d_out, int out_size, void* d_ws, size_t ws_size, hipStream_t stream) {
    static int grid_blocks = 0;
    if (!grid_blocks) {
        if (n_in != 26 || out_size != MROWS * DM || ws_size < WS_END) { fprintf(stderr, "kernel_launch: unexpected shapes n_in %d out %d ws %zu\n", n_in, out_size, ws_size); grid_blocks = -1; return; }
        int dev = 0, cus = 0, per_cu = 0;
        (void)hipGetDevice(&dev);
        (void)hipDeviceGetAttribute(&cus, hipDeviceAttributeMultiprocessorCount, dev);
        (void)hipFuncSetAttribute((const void*)mega, hipFuncAttributeMaxDynamicSharedMemorySize, LDS_BYTES);
        (void)hipOccupancyMaxActiveBlocksPerMultiprocessor(&per_cu, (const void*)mega, 512, LDS_BYTES);
        if (per_cu < 1) per_cu = 1;
        grid_blocks = cus * per_cu;
    }
    if (grid_blocks < 0) return;
    if (hipMemsetAsync((char*)d_ws + WS_BAR, 0, XCD_BAR_WORDS * sizeof(unsigned), stream) != hipSuccess) { fprintf(stderr, "kernel_launch: memset of the barrier words failed\n"); return; }
    Params p{};
    for (int i = 0; i < 26; ++i) p.in[i] = (const float*)d_in[i];
    p.out = (float*)d_out; p.ws = (unsigned char*)d_ws;
    void* args[] = {&p};
    hipError_t e = hipLaunchCooperativeKernel((void*)mega, dim3(grid_blocks), dim3(512), args, LDS_BYTES, stream);
    if (e != hipSuccess) fprintf(stderr, "cooperative launch failed: %s (grid %d)\n", hipGetErrorString(e), grid_blocks);
}
```

```cpp
#include <hip/hip_runtime.h>
#include <hip/hip_cooperative_groups.h>
#include <cstdio>
#include <cstdint>
namespace cg = cooperative_groups;
namespace pg8 {
#define PG8_LAS __attribute__((address_space(3)))
typedef unsigned short bf16_t;
typedef short bf16x8 __attribute__((ext_vector_type(8)));
typedef float f32x4 __attribute__((ext_vector_type(4)));
typedef unsigned u32x4 __attribute__((ext_vector_type(4)));
constexpr int BM = 256, BK = 64, HALF = 128, HTB = HALF * BK * 2  , STAGE_BYTES = 8 * HTB, NXCD = 8, WGM = 8;

__host__ __device__ __forceinline__ int lds_byte(int r, int c) { const int st = (r >> 4) * 2 + (c >> 5), rr = r & 15, cc = c & 31, ob = rr * 64 + cc * 2; return st * 1024 + (ob ^ (((ob >> 9) & 1) << 5)); }
__host__ __device__ __forceinline__ void stage_rc(int b, int& R, int& C) { const int st = b / 1024, sb = b % 1024, swz = sb ^ (((sb >> 9) & 1) << 5); R = (st >> 1) * 16 + swz / 64; C = (st & 1) * 32 + (swz % 64) / 2; }
__host__ __device__ __forceinline__ int perm32(int rho) { const int n = rho >> 4, i = rho & 15; return 8 * (i >> 2) + 4 * n + (i & 3); }

struct Unit { int pm, pn; };
struct Gemm { const bf16_t* A; const bf16_t* Bt; int M, N, K; };

struct StaticOrder {
    int nM, nN, nwg, G, c;
    __host__ __device__ void init(int M, int N, int G_, int c_) { nM = M / BM; nN = N / BM; nwg = nM * nN; G = G_; c = c_; }
    __host__ __device__ bool next(int i, Unit& u) const {
        const long L = (long)i * G + c; if (L >= nwg) return false;
        int wgid = (int)L; { const int q = nwg / NXCD, r = nwg % NXCD, xcd = wgid % NXCD, off = wgid / NXCD; wgid = (xcd < r ? xcd * (q + 1) : r * (q + 1) + (xcd - r) * q) + off; }
        const int nig = WGM * nN, gid = wgid / nig, fm = gid * WGM, gsz = (nM - fm) < WGM ? (nM - fm) : WGM;
        u.pm = fm + ((wgid % nig) % gsz); u.pn = (wgid % nig) / gsz; return true;
    }
    __device__ __forceinline__ void a_ready(const Unit&) const {}
    __device__ __forceinline__ void done(const Unit&) const {}
};


typedef float f32x2 __attribute__((ext_vector_type(2)));
typedef __bf16 bf16x2v __attribute__((ext_vector_type(2)));
__device__ __forceinline__ unsigned cvt_pk_bf16(float lo, float hi) { f32x2 v = {lo, hi}; bf16x2v b = __builtin_convertvector(v, bf16x2v); return __builtin_bit_cast(unsigned, b); }
__device__ __forceinline__ unsigned short cvt_bf16(float x) { return (unsigned short)(cvt_pk_bf16(x, 0.f) & 0xffffu); }
__device__ __forceinline__ float fast_sigmoid(float x) { return __builtin_amdgcn_rcpf(1.f + __builtin_amdgcn_exp2f(-1.4426950408889634f * x)); }
__device__ __forceinline__ void st8(bf16_t* p, const float* v) { u32x4 w; w.x = cvt_pk_bf16(v[0], v[1]); w.y = cvt_pk_bf16(v[2], v[3]); w.z = cvt_pk_bf16(v[4], v[5]); w.w = cvt_pk_bf16(v[6], v[7]); *(u32x4*)p = w; }

struct EpiSwiglu {
    static constexpr bool PERM = true, AFTER_DRAIN = false;
    bf16_t* O; int ldc;
    __device__ __forceinline__ void operator()(const f32x4 (&acc)[2][2][4][2], const Unit& u, int wr, int wc, int fr, int fq) const {
        const int row0 = u.pm * BM + wr * 64 + fr, col0 = u.pn * HALF + wc * 32 + 8 * fq;
#pragma unroll
        for (int ai = 0; ai < 2; ++ai)
#pragma unroll
            for (int m = 0; m < 4; ++m) {
                float v[8];
#pragma unroll
                for (int n = 0; n < 2; ++n)
#pragma unroll
                    for (int e = 0; e < 4; ++e) { const float g = acc[ai][0][m][n][e], up = acc[ai][1][m][n][e]; v[4 * n + e] = g * fast_sigmoid(g) * up; }
                { u32x4 w; w.x = cvt_pk_bf16(v[0], v[1]); w.y = cvt_pk_bf16(v[2], v[3]); w.z = cvt_pk_bf16(v[4], v[5]); w.w = cvt_pk_bf16(v[6], v[7]); __builtin_nontemporal_store(w, (u32x4*)(O + (size_t)(row0 + ai * HALF + m * 16) * ldc + col0)); }
            }
    }
};

struct EpiStoreSS {
    static constexpr bool PERM = true, AFTER_DRAIN = false;
    bf16_t* O; float* SSP;
    __device__ __forceinline__ void operator()(const f32x4 (&acc)[2][2][4][2], const Unit& u, int wr, int wc, int fr, int fq) const {
        const int row0 = u.pm * BM + wr * 64 + fr, col0 = u.pn * BM + wc * 32 + 8 * fq;
#pragma unroll
        for (int ai = 0; ai < 2; ++ai)
#pragma unroll
            for (int m = 0; m < 4; ++m) {
                const int row = row0 + ai * HALF + m * 16; float ss = 0.f;
#pragma unroll
                for (int bj = 0; bj < 2; ++bj) {
                    float v[8];
#pragma unroll
                    for (int n = 0; n < 2; ++n)
#pragma unroll
                        for (int e = 0; e < 4; ++e) { v[4 * n + e] = acc[ai][bj][m][n][e]; ss += v[4 * n + e] * v[4 * n + e]; }
                    st8(O + (size_t)row * 1024 + col0 + bj * HALF, v);
                }
                ss += __shfl_xor(ss, 16); ss += __shfl_xor(ss, 32);
                if (fq == 0) SSP[(size_t)row * 16 + u.pn * 4 + wc] = ss;
            }
    }
};

struct EpiWin {
    static constexpr bool PERM = true, AFTER_DRAIN = false;
    bf16_t *DQ, *DK, *DVT, *NQ, *KV6;
    float* GATES; const float* ROPE;
    __device__ __forceinline__ void operator()(const f32x4 (&acc)[2][2][4][2], const Unit& u, int wr, int wc, int fr, int fq) const {
        const int row0 = u.pm * BM + wr * 64 + fr;
#pragma unroll
        for (int bj = 0; bj < 2; ++bj) {
            const int cb = u.pn * BM + bj * HALF;
            const int col0 = cb + wc * 32 + 8 * fq;
            int kind; bf16_t* base = nullptr; int heads = 1, dshift = 6, c = 0;
            if (cb < 512)       { kind = 1; base = DQ;  c = col0; }
            else if (cb < 1024) { kind = 1; base = DK;  c = col0 - 512; }
            else if (cb < 1536) { kind = 2; base = DVT; c = col0 - 1024; heads = 4; dshift = 7; }
            else if (cb < 2048) { kind = 1; base = NQ;  c = col0 - 1536; }
            else if (cb < 2816) { const int idx = (cb - 2048) >> 7; base = KV6 + (size_t)idx * (16 * 2 * 2048 * 64); c = col0 - cb; heads = 2; dshift = 6;
                                  kind = (idx == 2 || idx == 4) ? 1 : ((idx == 3 || idx == 5) ? 2 : 0); }
            else if (cb == 2816) { kind = 3; c = col0 - 2816; }
            else { kind = 4; }
            if (kind == 4) continue;
            const float qsc = (cb < 512 || (cb >= 1536 && cb < 2048)) ? 0.18033688011112042f : 1.f;
            const int d0 = c & ((1 << dshift) - 1), hd = c >> dshift;
            int slabs = 8;
            if (cb >= 2048) slabs = 2;
#pragma unroll
            for (int ai = 0; ai < 2; ++ai)
#pragma unroll
                for (int m = 0; m < 4; ++m) {
                    const int row = row0 + ai * HALF + m * 16, b = row >> 11, t = row & 2047;
                    float v[8];
#pragma unroll
                    for (int n = 0; n < 2; ++n)
#pragma unroll
                        for (int e = 0; e < 4; ++e) v[4 * n + e] = acc[ai][bj][m][n][e] * qsc;
                    if (kind == 1) {
                        float pv[8];
#pragma unroll
                        for (int e = 0; e < 8; ++e) pv[e] = __shfl_xor(v[e], 16);
                        if (d0 < 16) {
                            const f32x4* cs = (const f32x4*)(ROPE + t * 16);
                            const f32x4 c0 = cs[0], c1 = cs[1], s0 = cs[2], s1 = cs[3];
                            const float sg = (d0 == 0) ? -1.f : 1.f;
#pragma unroll
                            for (int e = 0; e < 4; ++e) { v[e] = v[e] * c0[e] + sg * pv[e] * s0[e]; v[4 + e] = v[4 + e] * c1[e] + sg * pv[4 + e] * s1[e]; }
                        }
                    }
                    if (kind <= 1) {
                        st8(base + (((size_t)(b * slabs + hd) * 2048 + t) << 6) + d0, v);
                    } else if (kind == 2) {
                        bf16_t* p = base + ((size_t)((b * heads + hd) << dshift) + d0) * 2048 + t;
#pragma unroll
                        for (int e = 0; e < 8; ++e) p[(size_t)e * 2048] = cvt_bf16(v[e]);
                    } else {
                        if (c < 24) {
#pragma unroll
                            for (int e = 0; e < 8; ++e) GATES[(size_t)row * 24 + c + e] = fast_sigmoid(v[e]);
                        }
                    }
                }
        }
    }
};

template <class Epi, class Sched, bool ALIGN_EPI = false, bool SP2 = false>
__device__ __forceinline__ void gemm_phase(PG8_LAS unsigned char* lds, const Gemm g, const Sched& S, const Epi& E) {
    int tid_l = threadIdx.x; asm volatile("" : "+v"(tid_l));
    const int tid = tid_l, wid = __builtin_amdgcn_readfirstlane(tid >> 6), lane = tid & 63, wr = wid >> 2, wc = wid & 3, fr = lane & 15, fq = lane >> 4;
    const int K = g.K, nt = K / BK;
    unsigned voffA[2], voffB[2];
#pragma unroll
    for (int i = 0; i < 2; ++i) { int R, C; stage_rc(tid * 16 + i * 8192, R, C); const int Rb = Epi::PERM ? ((R & ~31) + perm32(R & 31)) : R;
        voffA[i] = (unsigned)(R * K + C) * 2u; voffB[i] = (unsigned)(Rb * K + C) * 2u; }
    const size_t kstep = (size_t)(BK * 2);
    const size_t hstep = (size_t)HALF * K * 2;
    const size_t tstep = 2 * hstep;
    const unsigned ldsw = (unsigned)wid * 1024u;
    const int aoff = lds_byte(wr * 64 + fr, fq * 8), boff = lds_byte(wc * 32 + fr, fq * 8);
#define PG8_SA(b, h) (((b) * 2 + (h)) * HTB)
#define PG8_SB(b, h) ((4 + (b) * 2 + (h)) * HTB)
#define PG8_STAGE(bufoff, gbase, voff) do { _Pragma("unroll") for (int _i = 0; _i < 2; ++_i) \
        __builtin_amdgcn_global_load_lds((const unsigned*)((const char*)(gbase) + (voff)[_i]), (PG8_LAS unsigned*)(lds + (bufoff) + ldsw + _i * 8192), 16, 0, 0); } while (0)
#define PG8_LDA(dst, b, h) do { _Pragma("unroll") for (int m = 0; m < 4; ++m) _Pragma("unroll") for (int k = 0; k < 2; ++k) dst[m][k] = *(const PG8_LAS bf16x8*)(lds + PG8_SA(b, h) + aoff + m * 2048 + k * 1024); } while (0)
#define PG8_LDB(dst, b, h) do { _Pragma("unroll") for (int n = 0; n < 2; ++n) _Pragma("unroll") for (int k = 0; k < 2; ++k) dst[n][k] = *(const PG8_LAS bf16x8*)(lds + PG8_SB(b, h) + boff + n * 2048 + k * 1024); } while (0)
#define PG8_MMA(ai, bj, At, Bt) do { __builtin_amdgcn_s_setprio(1); _Pragma("unroll") for (int m = 0; m < 4; ++m) _Pragma("unroll") for (int n = 0; n < 2; ++n) _Pragma("unroll") for (int k = 0; k < 2; ++k) \
        acc[ai][bj][m][n] = __builtin_amdgcn_mfma_f32_16x16x32_bf16(Bt[n][k], At[m][k], acc[ai][bj][m][n], 0, 0, 0); __builtin_amdgcn_s_setprio(0); } while (0)
#define PG8_WAIT_V(n) asm volatile("s_waitcnt vmcnt(" #n ")" ::: "memory")
#define PG8_WAIT_L(n) asm volatile("s_waitcnt lgkmcnt(" #n ")" ::: "memory")
#define PG8_BAR __builtin_amdgcn_s_barrier()
#define PG8_SCHED __builtin_amdgcn_sched_barrier(0)
    Unit cur, nxt; int ui = 0;
    if (!S.next(0, cur)) return;
    f32x4 acc[2][2][4][2];
#pragma unroll
    for (int a = 0; a < 2; ++a)
#pragma unroll
        for (int b = 0; b < 2; ++b)
#pragma unroll
            for (int m = 0; m < 4; ++m)
#pragma unroll
                for (int n = 0; n < 2; ++n) acc[a][b][m][n] = (f32x4){0.f, 0.f, 0.f, 0.f};
    bf16x8 At[4][2], B0[2][2], B1[2][2];
    const char* cA = (const char*)g.A + (size_t)cur.pm * tstep; const char* cB = (const char*)g.Bt + (size_t)cur.pn * tstep;
    S.a_ready(cur);
    if constexpr (SP2) {
        PG8_STAGE(PG8_SB(0, 0), cB, voffB); PG8_STAGE(PG8_SB(0, 1), cB + hstep, voffB); PG8_STAGE(PG8_SA(0, 0), cA, voffA); PG8_STAGE(PG8_SA(0, 1), cA + hstep, voffA);
        if (wr == 1) PG8_BAR;
        PG8_WAIT_V(2); PG8_BAR;
        PG8_STAGE(PG8_SB(1, 0), cB + kstep, voffB); PG8_STAGE(PG8_SA(1, 0), cA + kstep, voffA); PG8_STAGE(PG8_SB(1, 1), cB + hstep + kstep, voffB);
        PG8_WAIT_V(6); PG8_BAR;
    } else {
        PG8_STAGE(PG8_SB(0, 0), cB, voffB); PG8_STAGE(PG8_SA(0, 0), cA, voffA); PG8_STAGE(PG8_SB(0, 1), cB + hstep, voffB); PG8_STAGE(PG8_SA(0, 1), cA + hstep, voffA);
        if (wr == 1) PG8_BAR;
        PG8_WAIT_V(4); PG8_BAR;
        PG8_STAGE(PG8_SB(1, 0), cB + kstep, voffB); PG8_STAGE(PG8_SA(1, 0), cA + kstep, voffA); PG8_STAGE(PG8_SB(1, 1), cB + hstep + kstep, voffB);
        PG8_WAIT_V(6); PG8_BAR;
    }
    for (;;) {
        const bool has_next = S.next(ui + 1, nxt);
        const char* nA = has_next ? (const char*)g.A + (size_t)nxt.pm * tstep : cA; const char* nB = has_next ? (const char*)g.Bt + (size_t)nxt.pn * tstep : cB;
        for (int t = 0; t < nt; t += 2) {
            const bool last = (t == nt - 2);
            const char* a1 = cA + (size_t)(t + 1) * kstep;
            const char* a2 = last ? nA : cA + (size_t)(t + 2) * kstep; const char* b2 = last ? nB : cB + (size_t)(t + 2) * kstep;
            const char* a3 = a2 + kstep; const char* b3 = b2 + kstep;
            if (last && has_next) S.a_ready(nxt);
            if constexpr (SP2) {
            PG8_LDB(B0, 0, 0); PG8_LDB(B1, 0, 1); PG8_SCHED; PG8_LDA(At, 0, 0); PG8_STAGE(PG8_SA(1, 1), a1 + hstep, voffA);
            PG8_WAIT_V(8); PG8_WAIT_L(0); PG8_BAR; PG8_MMA(0, 0, At, B0); PG8_MMA(0, 1, At, B1); PG8_BAR; PG8_SCHED;
            PG8_LDA(At, 0, 1); PG8_STAGE(PG8_SB(0, 0), b2, voffB); PG8_STAGE(PG8_SB(0, 1), b2 + hstep, voffB); PG8_STAGE(PG8_SA(0, 0), a2, voffA);
            PG8_WAIT_V(8); PG8_WAIT_L(0); PG8_BAR; PG8_MMA(1, 0, At, B0); PG8_MMA(1, 1, At, B1); PG8_BAR; PG8_SCHED;
            PG8_LDB(B0, 1, 0); PG8_LDB(B1, 1, 1); PG8_SCHED; PG8_LDA(At, 1, 0); PG8_STAGE(PG8_SA(0, 1), a2 + hstep, voffA);
            PG8_WAIT_V(8); PG8_WAIT_L(0); PG8_BAR; PG8_MMA(0, 0, At, B0); PG8_MMA(0, 1, At, B1); PG8_BAR; PG8_SCHED;
            PG8_LDA(At, 1, 1); PG8_STAGE(PG8_SB(1, 0), b3, voffB); PG8_STAGE(PG8_SB(1, 1), b3 + hstep, voffB); PG8_STAGE(PG8_SA(1, 0), a3, voffA);
            PG8_WAIT_V(8); PG8_WAIT_L(0); PG8_BAR; PG8_MMA(1, 0, At, B0); PG8_MMA(1, 1, At, B1); PG8_BAR; PG8_SCHED;
            } else {
            PG8_LDB(B0, 0, 0); PG8_SCHED; PG8_LDA(At, 0, 0); PG8_STAGE(PG8_SA(1, 1), a1 + hstep, voffA);
            PG8_WAIT_L(8); PG8_BAR; PG8_WAIT_L(0); PG8_MMA(0, 0, At, B0); PG8_BAR; PG8_SCHED;
            PG8_LDB(B1, 0, 1); PG8_STAGE(PG8_SB(0, 0), b2, voffB);
            PG8_BAR; PG8_WAIT_L(0); PG8_MMA(0, 1, At, B1); PG8_BAR;
            PG8_LDA(At, 0, 1); PG8_STAGE(PG8_SA(0, 0), a2, voffA);
            PG8_BAR; PG8_WAIT_L(0); PG8_MMA(1, 0, At, B0); PG8_BAR; PG8_SCHED;
            PG8_STAGE(PG8_SB(0, 1), b2 + hstep, voffB);
            PG8_WAIT_V(6); PG8_BAR; PG8_MMA(1, 1, At, B1); PG8_BAR;
            PG8_LDB(B0, 1, 0); PG8_SCHED; PG8_LDA(At, 1, 0); PG8_STAGE(PG8_SA(0, 1), a2 + hstep, voffA);
            PG8_WAIT_L(8); PG8_BAR; PG8_WAIT_L(0); PG8_MMA(0, 0, At, B0); PG8_BAR; PG8_SCHED;
            PG8_LDB(B1, 1, 1); PG8_STAGE(PG8_SB(1, 0), b3, voffB);
            PG8_BAR; PG8_WAIT_L(0); PG8_MMA(0, 1, At, B1); PG8_BAR;
            PG8_LDA(At, 1, 1); PG8_STAGE(PG8_SA(1, 0), a3, voffA);
            PG8_BAR; PG8_WAIT_L(0); PG8_MMA(1, 0, At, B0); PG8_BAR; PG8_SCHED;
            PG8_STAGE(PG8_SB(1, 1), b3 + hstep, voffB);
            PG8_WAIT_V(6); PG8_BAR; PG8_MMA(1, 1, At, B1); PG8_BAR;
            }
        }
        if constexpr (ALIGN_EPI) { if (wr == 0) PG8_BAR; }
        if constexpr (!Epi::AFTER_DRAIN) { E(acc, cur, wr, wc, fr, fq); S.done(cur); }
        if (!has_next) break;
#pragma unroll
        for (int a = 0; a < 2; ++a)
#pragma unroll
            for (int b = 0; b < 2; ++b)
#pragma unroll
                for (int m = 0; m < 4; ++m)
#pragma unroll
                    for (int n = 0; n < 2; ++n) acc[a][b][m][n] = (f32x4){0.f, 0.f, 0.f, 0.f};
        cur = nxt; cA = nA; cB = nB; ++ui;
        if constexpr (ALIGN_EPI) { if (wr == 1) PG8_BAR; }
    }
    PG8_WAIT_V(0);
    if constexpr (!ALIGN_EPI) { if (wr == 0) PG8_BAR; }
    PG8_BAR;
    if constexpr (Epi::AFTER_DRAIN) { E.fused(acc, cur, wr, wc, fr, fq, lds, wid, lane); S.done(cur); }
#undef PG8_SA
#undef PG8_SB
#undef PG8_STAGE
#undef PG8_LDA
#undef PG8_LDB
#undef PG8_MMA
#undef PG8_WAIT_V
#undef PG8_WAIT_L
#undef PG8_BAR
#undef PG8_SCHED
}
}

#define DI __device__ __forceinline__
#define LAS __attribute__((address_space(3)))
typedef unsigned short bf16;
typedef short bf16x8 __attribute__((ext_vector_type(8)));
typedef short s16x4 __attribute__((ext_vector_type(4)));
typedef float f32x4 __attribute__((ext_vector_type(4)));
typedef float f32x16 __attribute__((ext_vector_type(16)));
typedef unsigned u32x2 __attribute__((ext_vector_type(2)));
typedef unsigned u32x4 __attribute__((ext_vector_type(4)));

constexpr int NB = 16, SQ = 2048, DM = 1024, MROWS = NB * SQ, FF = 2816, NGU = 2 * FF, NIN = 2840, NINP = 3072;
constexpr float EPS = 1e-6f;
constexpr size_t MiB = 1u << 20;
constexpr size_t WS_CTL = 0, WS_ROPE = 1 * MiB, WS_CBIAS = 1 * MiB + 256 * 1024, WS_CW2 = 1 * MiB + 512 * 1024, WS_KC = 2 * MiB, WS_VCT = 2 * MiB + 512 * 1024,
                 WS_CW1 = 3 * MiB, WS_SSP = 5 * MiB, WS_GATES = 7 * MiB, WS_WOUT = 10 * MiB, WS_WIN = 12 * MiB, WS_WGU1 = 18 * MiB, WS_WD1 = 29 * MiB,
                 WS_WGU2 = 35 * MiB, WS_WD2 = 46 * MiB, WS_XN = 64 * MiB, WS_HD = 128 * MiB, WS_HB = 192 * MiB,
                 WS_DQ = 192 * MiB, WS_DK = 224 * MiB, WS_DVT = 256 * MiB, WS_NQ = 288 * MiB, WS_KV6 = 320 * MiB, WS_XR = 370 * MiB, WS_END = 436 * MiB;
constexpr size_t KVSLAB = (size_t)16 * 2 * 2048 * 64;
constexpr int LDS_BYTES = 131072 + 256;
constexpr size_t WS_BAR = 64 * 1024;
constexpr float SCL2 = 0.125f * 1.4426950408889634f;

#ifndef PG8_ALIGN_SW
#define PG8_ALIGN_SW true
#endif
struct Params { const float* in[26]; float* out; unsigned char* ws; };

DI float wave_sum(float v) {
#pragma unroll
    for (int o = 1; o < 64; o <<= 1) v += __shfl_xor(v, o);
    return v;
}
DI unsigned pk2(float lo, float hi) { return pg8::cvt_pk_bf16(lo, hi); }
DI float bf2f(unsigned short b) { return __builtin_bit_cast(float, (unsigned)b << 16); }
#define MFMA32(a, b, c) __builtin_amdgcn_mfma_f32_32x32x16_bf16((a), (b), (c), 0, 0, 0)
DI int crow(int i, int h) { return (i & 3) + 8 * (i >> 2) + 4 * h; }

#define XB_TMO      128
#define XB_XCNT(j)  (256  + 64 * (j))
#define XB_XSUB(j)  (1280 + 64 * (j))
#define XB_XGEN(j)  (2304 + 64 * (j))
#define XB_TOP      3328
#define XB_TOPGEN   3392
#define XCD_BAR_WORDS 3456
#define XB_SPIN_CAP (1u << 18)

__device__ __forceinline__ unsigned xb_ld(unsigned* p)              { return __hip_atomic_load(p, __ATOMIC_RELAXED, __HIP_MEMORY_SCOPE_AGENT); }
__device__ __forceinline__ unsigned xb_add(unsigned* p, unsigned v) { return __hip_atomic_fetch_add(p, v, __ATOMIC_RELAXED, __HIP_MEMORY_SCOPE_AGENT); }
__device__ __forceinline__ unsigned xb_xcc_id() { return (unsigned)__builtin_amdgcn_s_getreg((3 << 11) | 20) & 0xFu; }
#define XB_SPIN(cond, bar) do { unsigned _sp = 0; while (cond) { __builtin_amdgcn_s_sleep(1); \
    if ((++_sp & 255u) == 0u) { if (xb_ld(&(bar)[XB_TMO])) break; if (_sp > XB_SPIN_CAP) { atomicAdd(&(bar)[XB_TMO], 1u); break; } } } } while (0)

struct XcdBarrier {
    unsigned* bar; unsigned x;
    volatile LAS unsigned* st;
};

__device__ __forceinline__ XcdBarrier xcd_barrier_post(unsigned* bar, volatile LAS unsigned* st) {
    XcdBarrier b; b.bar = bar; b.x = xb_xcc_id(); b.st = st;
    if (threadIdx.x == 0) (void)xb_add(&bar[XB_XCNT(b.x)], 1u);
    return b;
}
__device__ __forceinline__ void xcd_barrier_complete(unsigned* bar, unsigned x, unsigned& nloc, unsigned& nx) {
    const unsigned G = gridDim.x * gridDim.y * gridDim.z;
    unsigned sum, cnt, mine, sp = 0u;
    for (;;) {
        sum = 0u; cnt = 0u; mine = 0u;
#pragma unroll
        for (unsigned j = 0; j < 16; ++j) { const unsigned c = xb_ld(&bar[XB_XCNT(j)]); sum += c; cnt += (c > 0u) ? 1u : 0u; mine = (j == x) ? c : mine; }
        if (sum == G) break;
        __builtin_amdgcn_s_sleep(1);
        if ((++sp & 255u) == 0u) { if (xb_ld(&bar[XB_TMO])) break; if (sp > XB_SPIN_CAP) { atomicAdd(&bar[XB_TMO], 1u); break; } }
    }
    nloc = mine > 0u ? mine : 1u; nx = cnt > 0u ? cnt : 1u;
}

__device__ __forceinline__ void xcd_barrier(const XcdBarrier& b) {
    asm volatile("s_waitcnt vmcnt(0)" ::: "memory");
    __syncthreads();
    if (threadIdx.x == 0) {
        unsigned* bar = b.bar;
        __builtin_amdgcn_s_waitcnt(0);
        unsigned nloc = b.st[0], nx = b.st[1];
        if (nloc == 0u) { xcd_barrier_complete(bar, b.x, nloc, nx); b.st[0] = nloc; b.st[1] = nx; }
        const unsigned old = xb_add(&bar[XB_XSUB(b.x)], 1u);
        const unsigned gen = old / nloc;
        if (old + 1u == (gen + 1u) * nloc) {
            __builtin_amdgcn_fence(__ATOMIC_RELEASE, "agent");
            asm volatile("s_waitcnt vmcnt(0)" ::: "memory");
            const unsigned og = xb_add(&bar[XB_TOP], 1u);
            const unsigned tg = og / nx;
            if (og + 1u == (tg + 1u) * nx) xb_add(&bar[XB_TOPGEN], 1u);
            else XB_SPIN(xb_ld(&bar[XB_TOPGEN]) == tg, bar);
            __builtin_amdgcn_fence(__ATOMIC_ACQUIRE, "agent");
            xb_add(&bar[XB_XGEN(b.x)], 1u);
            asm volatile("s_waitcnt vmcnt(0)" ::: "memory");
        } else {
            XB_SPIN(xb_ld(&bar[XB_XGEN(b.x)]) == gen, bar);
            __builtin_amdgcn_fence(__ATOMIC_ACQUIRE, "agent");
            asm volatile("s_waitcnt vmcnt(0)" ::: "memory");
        }
    }
    __syncthreads();
}

template <bool FRAG = false>
DI void transpose_item(const float* W, int K, int N, bf16* WT, int destrow0, LAS float* scr, int k0, int n0, int lane, const float* gk = nullptr) {
    const int col = n0 + (lane & 31);
#pragma unroll
    for (int i = 0; i < 32; ++i) { const int kk = 2 * i + (lane >> 5); scr[kk * 33 + (lane & 31)] = (col < N) ? __builtin_nontemporal_load(W + (size_t)(k0 + kk) * N + col) : 0.f; }
    asm volatile("s_waitcnt lgkmcnt(0)" ::: "memory");
    const int c = lane & 7;
    f32x4 ga = {1.f, 1.f, 1.f, 1.f}, gb = ga;
    if (gk) { ga = *(const f32x4*)(gk + k0 + 8 * c); gb = *(const f32x4*)(gk + k0 + 8 * c + 4); }
#pragma unroll
    for (int j = 0; j < 4; ++j) { const int n = (lane >> 3) + 8 * j; const LAS float* s = scr + (8 * c) * 33 + n;
        u32x4 o; o.x = pk2(s[0 * 33] * ga[0], s[1 * 33] * ga[1]); o.y = pk2(s[2 * 33] * ga[2], s[3 * 33] * ga[3]); o.z = pk2(s[4 * 33] * gb[0], s[5 * 33] * gb[1]); o.w = pk2(s[6 * 33] * gb[2], s[7 * 33] * gb[3]);
        if (FRAG) {
            const int nn = destrow0 + n, kk = k0 + 8 * c;
            *(u32x4*)(WT + ((size_t)(((nn >> 5) * (K >> 4) + (kk >> 4)) * 64 + ((kk >> 3) & 1) * 32 + (nn & 31)) << 3)) = o;
        } else *(u32x4*)(WT + (size_t)(destrow0 + n) * K + k0 + 8 * c) = o; }
    asm volatile("s_waitcnt lgkmcnt(0)" ::: "memory");
}

DI void bf8_to_f32(const u32x4 w, f32x4& a, f32x4& b) {
    a[0] = __builtin_bit_cast(float, w.x << 16); a[1] = __builtin_bit_cast(float, w.x & 0xffff0000u); a[2] = __builtin_bit_cast(float, w.y << 16); a[3] = __builtin_bit_cast(float, w.y & 0xffff0000u);
    b[0] = __builtin_bit_cast(float, w.z << 16); b[1] = __builtin_bit_cast(float, w.z & 0xffff0000u); b[2] = __builtin_bit_cast(float, w.w << 16); b[3] = __builtin_bit_cast(float, w.w & 0xffff0000u);
}
template <bool HAS_H, int XIN, int XOUT, bool WRITE_XN>
DI void rows_phase(const void* xin_, const bf16* HD, const float* SSP, const float* gpost, float sc, void* xout_, const float* gpre, bf16* XN, float* RI, int gw, int NGW, int lane) {
    for (int m0 = gw; m0 < MROWS; m0 += 2 * NGW) {
        f32x4 v[2][4]; u32x4 hb[2][2]; f32x4 sp[2][4];
#pragma unroll
        for (int rr = 0; rr < 2; ++rr) {
            const int m = m0 + rr * NGW;
            if (XIN == 0) {
                const float* xr = (const float*)xin_ + (size_t)m * DM + 8 * lane;
#pragma unroll
                for (int hf = 0; hf < 2; ++hf) { v[rr][2 * hf] = __builtin_nontemporal_load((const f32x4*)(xr + 512 * hf)); v[rr][2 * hf + 1] = __builtin_nontemporal_load((const f32x4*)(xr + 512 * hf + 4)); }
            } else {
                const bf16* xr = (const bf16*)xin_ + (size_t)m * DM + 8 * lane;
                const float ri = RI[m];
#pragma unroll
                for (int hf = 0; hf < 2; ++hf) { const u32x4 w = *(const u32x4*)(xr + 512 * hf); bf8_to_f32(w, v[rr][2 * hf], v[rr][2 * hf + 1]); v[rr][2 * hf] *= ri; v[rr][2 * hf + 1] *= ri; }
            }
            if (HAS_H) {
                const f32x4* spp = (const f32x4*)(SSP + (size_t)m * 16);
                const bf16* hr = HD + (size_t)m * DM + 8 * lane;
#pragma unroll
                for (int j = 0; j < 4; ++j) sp[rr][j] = spp[j];
#pragma unroll
                for (int hf = 0; hf < 2; ++hf) hb[rr][hf] = __builtin_nontemporal_load((const u32x4*)(hr + 512 * hf));
            }
        }
#pragma unroll
        for (int rr = 0; rr < 2; ++rr) {
            const int m = m0 + rr * NGW;
            if (HAS_H) {
                float ss = 0.f;
#pragma unroll
                for (int j = 0; j < 4; ++j) ss += (sp[rr][j][0] + sp[rr][j][1]) + (sp[rr][j][2] + sp[rr][j][3]);
                const float rh = sc * __builtin_amdgcn_rsqf(ss * (1.f / DM) + EPS);
#pragma unroll
                for (int hf = 0; hf < 2; ++hf) {
                    f32x4 ha, hb2; bf8_to_f32(hb[rr][hf], ha, hb2);
                    const f32x4 g0 = *(const f32x4*)(gpost + 512 * hf + 8 * lane), g1 = *(const f32x4*)(gpost + 512 * hf + 8 * lane + 4);
                    v[rr][2 * hf] += ha * rh * g0; v[rr][2 * hf + 1] += hb2 * rh * g1;
                }
            }
            if (XOUT == 2) {
                float* xo = (float*)xout_ + (size_t)m * DM + 8 * lane;
#pragma unroll
                for (int hf = 0; hf < 2; ++hf) { __builtin_nontemporal_store(v[rr][2 * hf], (f32x4*)(xo + 512 * hf)); __builtin_nontemporal_store(v[rr][2 * hf + 1], (f32x4*)(xo + 512 * hf + 4)); }
            }
            if (WRITE_XN) {
                float s2 = 0.f;
#pragma unroll
                for (int j = 0; j < 4; ++j) s2 += (v[rr][j][0] * v[rr][j][0] + v[rr][j][1] * v[rr][j][1]) + (v[rr][j][2] * v[rr][j][2] + v[rr][j][3] * v[rr][j][3]);
                const float ms = wave_sum(s2) * (1.f / DM) + EPS, rs = __builtin_amdgcn_rsqf(ms);
                if (lane == 0) RI[m] = ms * rs;
                bf16* o8 = XN + (size_t)m * DM + 8 * lane;
#pragma unroll
                for (int hf = 0; hf < 2; ++hf) { const f32x4 a = v[rr][2 * hf] * rs, b = v[rr][2 * hf + 1] * rs;
                    u32x4 o; o.x = pk2(a[0], a[1]); o.y = pk2(a[2], a[3]); o.z = pk2(b[0], b[1]); o.w = pk2(b[2], b[3]); *(u32x4*)(o8 + 512 * hf) = o; }
            }
        }
    }
}

DI void compress_unit(int unit, const bf16* KV6, const bf16* CW1, const float* CBIAS, const bf16* CW2, bf16* KC, bf16* VCT, LAS unsigned char* lds, int wave, int lane, int tid) {
    const int kv = unit >> 7, bg = (unit >> 2) & 31, ct = unit & 3, r = lane & 31, h = lane >> 5;
    {
        const bf16* srcg = KV6 + (size_t)kv * KVSLAB + ((size_t)bg * 2048 + 512 * ct) * 64;
#pragma unroll
        for (int i = 0; i < 9; ++i) {
            const unsigned idx = (unsigned)tid + 512u * i;
            if (idx < 4224u) { const unsigned tk = idx >> 3, ch = idx & 7u; *(LAS u32x4*)(lds + tk * 128u + (tk >> 4) * 16u + ch * 16u) = *(const u32x4*)(srcg + idx * 8u); }
        }
    }
    __syncthreads();
    const bf16* w1 = CW1 + (size_t)kv * 256 * 2048 + ((size_t)wave * 128 * 64 + lane) * 8;
    f32x16 hacc;
#pragma unroll
    for (int i = 0; i < 16; ++i) hacc[i] = 0.f;
#pragma unroll 1
    for (int kb = 0; kb < 128; kb += 16) {
        bf16x8 a[16];
#pragma unroll
        for (int j = 0; j < 16; ++j) a[j] = *(const bf16x8*)(w1 + (size_t)(kb + j) * 512);
#pragma unroll
        for (int j = 0; j < 16; ++j) {
            const int ks = kb + j;
            const unsigned tk = 16u * r + (unsigned)(ks >> 2);
            const bf16x8 b = *(LAS const bf16x8*)(lds + tk * 128u + (tk >> 4) * 16u + (unsigned)(((ks & 3) * 16 + 8 * h) * 2));
            hacc = MFMA32(a[j], b, hacc);
        }
    }
    __syncthreads();
    const float* bias = CBIAS + kv * 256 + 32 * wave + 4 * h;
    float g[16];
#pragma unroll
    for (int a4 = 0; a4 < 4; ++a4) { const f32x4 bv = *(const f32x4*)(bias + 8 * a4);
#pragma unroll
        for (int e = 0; e < 4; ++e) { const float x = hacc[4 * a4 + e] + bv[e]; const float u2 = 2.f * 0.7978845608028654f * (x + 0.044715f * x * x * x);
            g[4 * a4 + e] = x * __builtin_amdgcn_rcpf(1.f + __builtin_amdgcn_exp2f(-1.4426950408889634f * u2)); } }
    f32x16 o2[2];
#pragma unroll
    for (int db = 0; db < 2; ++db)
#pragma unroll
        for (int i = 0; i < 16; ++i) o2[db][i] = 0.f;
    const bf16* w2 = CW2 + (size_t)kv * 64 * 256 + 32 * wave + 4 * h;
#pragma unroll
    for (int s = 0; s < 2; ++s) {
        u32x4 pb; pb.x = pk2(g[8 * s + 0], g[8 * s + 1]); pb.y = pk2(g[8 * s + 2], g[8 * s + 3]); pb.z = pk2(g[8 * s + 4], g[8 * s + 5]); pb.w = pk2(g[8 * s + 6], g[8 * s + 7]);
        const bf16x8 pbv = __builtin_bit_cast(bf16x8, pb);
#pragma unroll
        for (int db = 0; db < 2; ++db) {
            const bf16* wp = w2 + (size_t)(32 * db + r) * 256 + 16 * s;
            const s16x4 lo = *(const s16x4*)wp, hi = *(const s16x4*)(wp + 8);
            const bf16x8 af = __builtin_shufflevector(lo, hi, 0, 1, 2, 3, 4, 5, 6, 7);
            o2[db] = MFMA32(af, pbv, o2[db]);
        }
    }
    LAS float* red = (LAS float*)lds;
#pragma unroll
    for (int db = 0; db < 2; ++db)
#pragma unroll
        for (int i = 0; i < 16; ++i) red[(wave * 32 + db * 16 + i) * 64 + lane] = o2[db][i];
    __syncthreads();
    for (int e = tid; e < 2048; e += 512) {
        float s = 0.f;
#pragma unroll
        for (int w = 0; w < 8; ++w) s += red[w * 2048 + e];
        const int ln = e & 63, ri = e >> 6, db = ri >> 4, i = ri & 15, c = 32 * ct + (ln & 31), d = 32 * db + crow(i, ln >> 5);
        if (c == 127) s = 0.f;
        const unsigned short bv = pg8::cvt_bf16(s);
        if (kv == 0) KC[((size_t)bg * 128 + c) * 64 + d] = bv; else VCT[((size_t)bg * 64 + d) * 128 + c] = bv;
    }
    __syncthreads();
}

template <int MODE> DI bool key_valid(int key, int t, unsigned selmask) {
    if (MODE == 0) return key <= t;
    if (MODE == 1) return key <= t && key + 512 > t;
    if (MODE == 2) return key <= t && ((selmask >> (key >> 6)) & 1u);
    return key <= 126 && 16 * key + 31 <= t;
}
DI void load_q(bf16x8 (&qf)[4], const bf16* Qrow  ) {
#pragma unroll
    for (int ks = 0; ks < 4; ++ks) qf[ks] = *(const bf16x8*)(Qrow + 16 * ks);
}
DI f32x16 qk_tile(const bf16* Kt  , const bf16x8 (&qf)[4]) {
    f32x16 s;
#pragma unroll
    for (int i = 0; i < 16; ++i) s[i] = 0.f;
    bf16x8 kf[4];
#pragma unroll
    for (int ks = 0; ks < 4; ++ks) kf[ks] = *(const bf16x8*)(Kt + 16 * ks);
#pragma unroll
    for (int ks = 0; ks < 4; ++ks) s = MFMA32(kf[ks], qf[ks], s);
    return s;
}
template <int NDB, int MODE>
DI void attn_tile(const bf16* Kt, const bf16* Vt  , int ldv, const bf16x8 (&qf)[4], f32x16 (&o)[NDB], float& m, float& l, int key0, int t, int h, unsigned selmask) {
    f32x16 s = qk_tile(Kt, qf);
    __builtin_amdgcn_sched_barrier(0);
    float mx = -INFINITY;
#pragma unroll
    for (int i = 0; i < 16; ++i) { s[i] = key_valid<MODE>(key0 + crow(i, h), t, selmask) ? s[i] * SCL2 : -INFINITY; mx = fmaxf(mx, s[i]); }
    mx = fmaxf(mx, __shfl_xor(mx, 32));
    const float mn = fmaxf(m, mx), mu = (mn == -INFINITY) ? 0.f : mn;
    const float alpha = __builtin_amdgcn_exp2f(m - mu);
    float ps = 0.f;
#pragma unroll
    for (int i = 0; i < 16; ++i) { s[i] = __builtin_amdgcn_exp2f(s[i] - mu); ps += s[i]; }
    l = l * alpha + ps; m = mn;
#pragma unroll
    for (int db = 0; db < NDB; ++db)
#pragma unroll
        for (int i = 0; i < 16; ++i) o[db][i] *= alpha;
#pragma unroll
    for (int sI = 0; sI < 2; ++sI) {
        u32x4 pb; pb.x = pk2(s[8 * sI + 0], s[8 * sI + 1]); pb.y = pk2(s[8 * sI + 2], s[8 * sI + 3]); pb.z = pk2(s[8 * sI + 4], s[8 * sI + 5]); pb.w = pk2(s[8 * sI + 6], s[8 * sI + 7]);
        const bf16x8 pbv = __builtin_bit_cast(bf16x8, pb);
#pragma unroll
        for (int db = 0; db < NDB; ++db) {
            const bf16* vp = Vt + (size_t)(32 * db) * ldv + 16 * sI;
            const s16x4 lo = *(const s16x4*)vp, hi = *(const s16x4*)(vp + 8);
            const bf16x8 vf = __builtin_shufflevector(lo, hi, 0, 1, 2, 3, 4, 5, 6, 7);
            o[db] = MFMA32(vf, pbv, o[db]);
        }
    }
}
template <int NDB> DI void zero_o(f32x16 (&o)[NDB]) {
#pragma unroll
    for (int db = 0; db < NDB; ++db)
#pragma unroll
        for (int i = 0; i < 16; ++i) o[db][i] = 0.f;
}

DI void diff_unit(int b, int hh, int qt, float lam, const bf16* DQ, const bf16* DK, const bf16* DVT, const float* subln, bf16* AO, int lane) {
    const int r = lane & 31, h = lane >> 5, q0 = 32 * qt, t = q0 + r;
    f32x16 o0[4], o1[4];
    const bf16* Vb = DVT + (size_t)(b * 4 + hh) * 128 * 2048 + (size_t)r * 2048 + 4 * h;
#pragma unroll
    for (int mm = 0; mm < 2; ++mm) {
        const size_t slab = ((size_t)((b * 4 + hh) * 2 + mm) * 2048) * 64;
        bf16x8 qf[4]; load_q(qf, DQ + slab + (size_t)t * 64 + 8 * h);
        const bf16* Kb = DK + slab + (size_t)r * 64 + 8 * h;
        float m = -INFINITY, l = 0.f;
        zero_o<4>(o1);
        for (int kt = 0; kt <= qt; ++kt)
            attn_tile<4, 0>(Kb + (size_t)kt * 32 * 64, Vb + kt * 32, 2048, qf, o1, m, l, kt * 32, t, h, 0u);
        l += __shfl_xor(l, 32);
        const float inv = (l > 0.f) ? 1.f / l : 0.f;
        if (mm == 0) {
#pragma unroll
            for (int db = 0; db < 4; ++db)
#pragma unroll
                for (int i = 0; i < 16; ++i) o0[db][i] = o1[db][i] * inv;
        } else {
#pragma unroll
            for (int db = 0; db < 4; ++db)
#pragma unroll
                for (int i = 0; i < 16; ++i) o0[db][i] -= lam * inv * o1[db][i];
        }
    }
    float ss = 0.f;
#pragma unroll
    for (int db = 0; db < 4; ++db)
#pragma unroll
        for (int i = 0; i < 16; ++i) ss += o0[db][i] * o0[db][i];
    ss += __shfl_xor(ss, 32);
    const float rs = __builtin_amdgcn_rsqf(ss * (1.f / 128.f) + EPS) * 0.8f;
    bf16* orow = AO + (size_t)(b * 2048 + t) * 1024 + hh * 128 + 4 * h;
#pragma unroll
    for (int db = 0; db < 4; ++db)
#pragma unroll
        for (int a = 0; a < 4; ++a) {
            const f32x4 g = *(const f32x4*)(subln + 32 * db + 8 * a + 4 * h);
            u32x2 w; w.x = pk2(o0[db][4 * a + 0] * rs * g[0], o0[db][4 * a + 1] * rs * g[1]); w.y = pk2(o0[db][4 * a + 2] * rs * g[2], o0[db][4 * a + 3] * rs * g[3]);
            *(u32x2*)(orow + 32 * db + 8 * a) = w;
        }
}

DI void nsa_unit(int b, int g, int qt, const bf16* NQ, const bf16* KC, const bf16* VCT, const bf16* KV6, const float* GATES, bf16* AO, int lane) {
    const int r = lane & 31, h = lane >> 5, q0 = 32 * qt, t = q0 + r, bg = b * 2 + g;
    const bf16* KCb = KC + (size_t)bg * 128 * 64 + (size_t)r * 64 + 8 * h;
    const bf16* VCb = VCT + (size_t)bg * 64 * 128 + (size_t)r * 128 + 4 * h;
    const size_t kvoff = (size_t)bg * 2048 * 64;
    const bf16* KSb = KV6 + 2 * KVSLAB + kvoff + (size_t)r * 64 + 8 * h;
    const bf16* VSb = KV6 + 3 * KVSLAB + kvoff + (size_t)r * 2048 + 4 * h;
    const bf16* KWb = KV6 + 4 * KVSLAB + kvoff + (size_t)r * 64 + 8 * h;
    const bf16* VWb = KV6 + 5 * KVSLAB + kvoff + (size_t)r * 2048 + 4 * h;
    float imp[16];
#pragma unroll
    for (int i = 0; i < 16; ++i) imp[i] = 0.f;
#ifndef X_NOPASS1
#pragma unroll 1
    for (int hq = 0; hq < 4; ++hq) {
        bf16x8 qf[4]; load_q(qf, NQ + ((size_t)(b * 8 + g * 4 + hq) * 2048 + t) * 64 + 8 * h);
        f32x16 s[4]; float mx = -INFINITY;
#pragma unroll
        for (int T = 0; T < 4; ++T) {
            s[T] = qk_tile(KCb + (size_t)T * 32 * 64, qf);
            __builtin_amdgcn_sched_barrier(0);
#pragma unroll
            for (int i = 0; i < 16; ++i) { s[T][i] = key_valid<3>(32 * T + crow(i, h), t, 0u) ? s[T][i] : -INFINITY; mx = fmaxf(mx, s[T][i]); }
            __builtin_amdgcn_sched_barrier(0);
        }
        mx = fmaxf(mx, __shfl_xor(mx, 32));
        const float mu = (mx == -INFINITY) ? 0.f : mx;
        float ps = 0.f;
#pragma unroll
        for (int T = 0; T < 4; ++T)
#pragma unroll
            for (int i = 0; i < 16; ++i) { s[T][i] = __builtin_amdgcn_exp2f(s[T][i] - mu); ps += s[T][i]; }
        ps += __shfl_xor(ps, 32);
        const float inv = (ps > 0.f) ? 1.f / ps : 0.f;
        float xs[16];
#pragma unroll
        for (int idx = 0; idx < 16; ++idx) xs[idx] = __shfl_xor(s[idx >> 2][4 * (idx & 3) + 3], 32);
#pragma unroll
        for (int idx = 0; idx < 16; ++idx) {
            const int T = idx >> 2, a = idx & 3;
            const float w = s[T][4 * a] + s[T][4 * a + 1] + s[T][4 * a + 2] + 0.5f * s[T][4 * a + 3];
            const float cprev = (idx > 0) ? xs[idx > 0 ? idx - 1 : 0] : 0.f;
            const float carry = h ? xs[idx] : cprev;
            imp[idx] += (w + 0.5f * carry) * inv;
        }
    }
#endif
    unsigned selmask;
#ifdef X_NOTOPK
    selmask = (unsigned)imp[0];
#else
    {
        const int cur = t >> 6;
        float val[16], oth[16];
#pragma unroll
        for (int idx = 0; idx < 16; ++idx) { const int j = 2 * idx + h; const bool forced = (j == 0) || (j == cur) || (j == cur - 1);
            val[idx] = forced ? 1e9f : ((j <= cur) ? imp[idx] : -1.f); }
#pragma unroll
        for (int idx = 0; idx < 16; ++idx) oth[idx] = __shfl_xor(val[idx], 32);
        unsigned bits = 0u;
#pragma unroll
        for (int idx = 0; idx < 16; ++idx) {
            const int j = 2 * idx + h; const float v = val[idx]; int rank = 0;
#pragma unroll
            for (int i2 = 0; i2 < 16; ++i2) {
                const int j2 = 2 * i2 + h, j3 = 2 * i2 + 1 - h;
                rank += (val[i2] > v || (val[i2] == v && j2 < j)) ? 1 : 0;
                rank += (oth[i2] > v || (oth[i2] == v && j3 < j)) ? 1 : 0;
                asm volatile("" : "+v"(rank));
            }
            bits |= (rank < 16) ? (1u << j) : 0u;
        }
        selmask = bits | (unsigned)__shfl_xor((int)bits, 32);
    }
#endif
#pragma unroll 1
    for (int hq = 0; hq < 4; ++hq) {
        const int head = g * 4 + hq;
        bf16x8 qf[4]; load_q(qf, NQ + ((size_t)(b * 8 + head) * 2048 + t) * 64 + 8 * h);
        const float* gp = GATES + (size_t)(b * 2048 + t) * 24 + head * 3;
        const float g0 = gp[0], g1 = gp[1], g2 = gp[2];
        f32x16 out[2], o[2];
        zero_o<2>(out);
#ifndef X_NOCMP
        {
            float m = -INFINITY, l = 0.f; zero_o<2>(o);
#pragma unroll 1
            for (int T = 0; T < 4; ++T) attn_tile<2, 3>(KCb + (size_t)T * 32 * 64, VCb + T * 32, 128, qf, o, m, l, T * 32, t, h, 0u);
            l += __shfl_xor(l, 32); const float f = (l > 0.f) ? g0 / l : 0.f;
#pragma unroll
            for (int db = 0; db < 2; ++db)
#pragma unroll
                for (int i = 0; i < 16; ++i) out[db][i] += f * o[db][i];
        }
#endif
#ifndef X_NOSEL
        {
            float m = -INFINITY, l = 0.f; zero_o<2>(o);
#pragma unroll 1
            for (int kt = 0; kt <= qt; ++kt) {
                if (!__any((int)((selmask >> (kt >> 1)) & 1u))) continue;
                attn_tile<2, 2>(KSb + (size_t)kt * 32 * 64, VSb + kt * 32, 2048, qf, o, m, l, kt * 32, t, h, selmask);
            }
            l += __shfl_xor(l, 32); const float f = (l > 0.f) ? g1 / l : 0.f;
#pragma unroll
            for (int db = 0; db < 2; ++db)
#pragma unroll
                for (int i = 0; i < 16; ++i) out[db][i] += f * o[db][i];
        }
#endif
#ifndef X_NOWIN
        {
            float m = -INFINITY, l = 0.f; zero_o<2>(o);
            const int klo = (qt > 16) ? qt - 16 : 0;
#pragma unroll 1
            for (int kt = klo; kt <= qt; ++kt) attn_tile<2, 1>(KWb + (size_t)kt * 32 * 64, VWb + kt * 32, 2048, qf, o, m, l, kt * 32, t, h, 0u);
            l += __shfl_xor(l, 32); const float f = (l > 0.f) ? g2 / l : 0.f;
#pragma unroll
            for (int db = 0; db < 2; ++db)
#pragma unroll
                for (int i = 0; i < 16; ++i) out[db][i] += f * o[db][i];
        }
#endif
        bf16* orow = AO + (size_t)(b * 2048 + t) * 1024 + 512 + head * 64 + 4 * h;
#pragma unroll
        for (int db = 0; db < 2; ++db)
#pragma unroll
            for (int a = 0; a < 4; ++a) {
                u32x2 w; w.x = pk2(out[db][4 * a + 0], out[db][4 * a + 1]); w.y = pk2(out[db][4 * a + 2], out[db][4 * a + 3]);
                *(u32x2*)(orow + 32 * db + 8 * a) = w;
            }
    }
}


constexpr int KSTR = 72, VSTR = 68;
constexpr int KBUF_B = 64 * KSTR * 2, VBUF_B = 128 * VSTR * 2, ABUF_B = KBUF_B + VBUF_B;
constexpr int NBUF_B = KBUF_B + 64 * VSTR * 2;
constexpr int A_IMPX = 73728, A_MISC = A_IMPX + 8 * 16 * 64 * 4;
static_assert(4 * NBUF_B <= A_IMPX && 2 * ABUF_B <= A_IMPX && A_MISC + 256 <= 131072, "attention LDS map");
template <int NV> struct Stage { u32x4 k; u32x4 v[NV]; };
template <int NV> DI void stage_load(Stage<NV>& st, const bf16* Kg, const bf16* Vg, int ldv, int tid) {
    const unsigned ut = (unsigned)tid;
    st.k = *(const u32x4*)(Kg + ((ut >> 3) * 64u + (ut & 7u) * 8u));
#pragma unroll
    for (int i = 0; i < NV; ++i) { const unsigned idx = ut + 512u * i; st.v[i] = *(const u32x4*)(Vg + ((idx >> 3) * (unsigned)ldv + (idx & 7u) * 8u)); }
}
template <int NV> DI void stage_store(const Stage<NV>& st, LAS unsigned char* buf, int tid) {
    *(LAS u32x4*)(buf + ((tid >> 3) * KSTR + (tid & 7) * 8) * 2) = st.k;
#pragma unroll
    for (int i = 0; i < NV; ++i) { const int idx = tid + 512 * i; LAS unsigned char* q = buf + KBUF_B + ((idx >> 3) * VSTR + (idx & 7) * 8) * 2;
        u32x2 a; a.x = st.v[i].x; a.y = st.v[i].y; u32x2 b; b.x = st.v[i].z; b.y = st.v[i].w;
        *(LAS u32x2*)q = a; *(LAS u32x2*)(q + 8) = b; }
}
template <int NDB, int MODE, bool MASKED>
DI void tile_compute(LAS const unsigned char* buf, const bf16x8 (&qf)[4], f32x16 (&o)[NDB], float& m, float& l, int key0, int t, int r, int h, unsigned selmask) {
#pragma unroll
    for (int sub = 0; sub < 2; ++sub) {
        f32x16 s;
#pragma unroll
        for (int i = 0; i < 16; ++i) s[i] = 0.f;
        bf16x8 kf[4];
        LAS const unsigned char* kp = buf + ((sub * 32 + r) * KSTR + 8 * h) * 2;
#pragma unroll
        for (int ks = 0; ks < 4; ++ks) kf[ks] = *(LAS const bf16x8*)(kp + 32 * ks);
#pragma unroll
        for (int ks = 0; ks < 4; ++ks) s = MFMA32(kf[ks], qf[ks], s);
        __builtin_amdgcn_sched_barrier(0);
        float mx = -INFINITY;
        if (MASKED) {
#pragma unroll
            for (int i = 0; i < 16; ++i) { s[i] = key_valid<MODE>(key0 + 32 * sub + crow(i, h), t, selmask) ? s[i] : -INFINITY; mx = fmaxf(mx, s[i]); }
        } else {
#pragma unroll
            for (int i = 0; i < 16; ++i) mx = fmaxf(mx, s[i]);
        }
        mx = fmaxf(mx, __shfl_xor(mx, 32));
        const bool need = mx > m + 8.f;
        if (__any((int)need)) {
            const float mn = need ? mx : m;
            const float alpha = need ? __builtin_amdgcn_exp2f(m - mn) : 1.f;
            l *= alpha; m = mn;
#pragma unroll
            for (int db = 0; db < NDB; ++db)
#pragma unroll
                for (int i = 0; i < 16; ++i) o[db][i] *= alpha;
        }
        const float mu = (m == -INFINITY) ? 0.f : m;
        float ps = 0.f;
#pragma unroll
        for (int i = 0; i < 16; ++i) { s[i] = __builtin_amdgcn_exp2f(s[i] - mu); ps += s[i]; }
        l += ps;
#pragma unroll
        for (int sI = 0; sI < 2; ++sI) {
            u32x4 pb; pb.x = pk2(s[8 * sI + 0], s[8 * sI + 1]); pb.y = pk2(s[8 * sI + 2], s[8 * sI + 3]); pb.z = pk2(s[8 * sI + 4], s[8 * sI + 5]); pb.w = pk2(s[8 * sI + 6], s[8 * sI + 7]);
            const bf16x8 pbv = __builtin_bit_cast(bf16x8, pb);
#pragma unroll
            for (int db = 0; db < NDB; ++db) {
                LAS const unsigned char* vp = buf + KBUF_B + ((32 * db + r) * VSTR + 32 * sub + 16 * sI + 4 * h) * 2;
                const s16x4 lo = *(LAS const s16x4*)vp, hi = *(LAS const s16x4*)(vp + 16);
                const bf16x8 vf = __builtin_shufflevector(lo, hi, 0, 1, 2, 3, 4, 5, 6, 7);
                o[db] = MFMA32(vf, pbv, o[db]);
            }
        }
    }
}
template <int NDB, int MODE>
DI void flash_block(const bf16* Kg, const bf16* Vg, int ldv, unsigned tiles, LAS unsigned char* lds, const bf16x8 (&qf)[4], f32x16 (&o)[NDB], float& m, float& l,
                    int t, int qlo, int r, int h, unsigned selmask, int tid) {
    Stage<NDB / 2> st;
    unsigned rem = tiles; int cur = -1, bufi = 0;
    if (rem) { cur = __builtin_ctz(rem); rem &= rem - 1u; stage_load(st, Kg + (size_t)cur * 64 * 64, Vg + cur * 64, ldv, tid); }
    __syncthreads();
    while (cur >= 0) {
        LAS unsigned char* buf = lds + bufi * ABUF_B;
        stage_store(st, buf, tid);
        int nxt = -1;
        if (rem) { nxt = __builtin_ctz(rem); rem &= rem - 1u; stage_load(st, Kg + (size_t)nxt * 64 * 64, Vg + nxt * 64, ldv, tid); }
        __syncthreads();
        const int key0 = cur * 64;
        bool rel = true, msk = true;
        if (MODE == 0) { rel = key0 <= qlo + 31; msk = key0 + 63 > qlo; }
        if (MODE == 1) { rel = key0 <= qlo + 31 && key0 + 63 + 512 > qlo; msk = (key0 + 63 > qlo) || (key0 + 512 <= qlo + 31); }
        if (MODE == 2) { const int bit = (int)((selmask >> cur) & 1u); rel = key0 <= qlo + 31 && __any(bit); msk = (key0 + 63 > qlo) || !__all(bit); }
        if (rel) {
            if (msk) tile_compute<NDB, MODE, true>(buf, qf, o, m, l, key0, t, r, h, selmask);
            else tile_compute<NDB, MODE, false>(buf, qf, o, m, l, key0, t, r, h, selmask);
        }
        cur = nxt; bufi ^= 1;
    }
}

template <int MODE>
DI void flash_block2(const bf16* Kg, const bf16* Vg, int ldv, unsigned tiles, LAS unsigned char* lds, const bf16x8 (&qf)[4], f32x16 (&o)[2], float& m, float& l,
                     int t, int qlo, int r, int h, unsigned selmask, int tid) {
    Stage<1> st0, st1;
    unsigned rem = tiles; int c0 = -1, c1 = -1, bufi = 0;
    if (rem) { c0 = __builtin_ctz(rem); rem &= rem - 1u; stage_load(st0, Kg + (size_t)c0 * 64 * 64, Vg + c0 * 64, ldv, tid); }
    if (rem) { c1 = __builtin_ctz(rem); rem &= rem - 1u; stage_load(st1, Kg + (size_t)c1 * 64 * 64, Vg + c1 * 64, ldv, tid); }
    __syncthreads();
    while (c0 >= 0) {
        LAS unsigned char* bufa = lds + (2 * bufi) * NBUF_B;
        LAS unsigned char* bufb = bufa + NBUF_B;
        stage_store(st0, bufa, tid);
        if (c1 >= 0) stage_store(st1, bufb, tid);
        int n0 = -1, n1 = -1;
        if (rem) { n0 = __builtin_ctz(rem); rem &= rem - 1u; stage_load(st0, Kg + (size_t)n0 * 64 * 64, Vg + n0 * 64, ldv, tid); }
        if (rem) { n1 = __builtin_ctz(rem); rem &= rem - 1u; stage_load(st1, Kg + (size_t)n1 * 64 * 64, Vg + n1 * 64, ldv, tid); }
        __syncthreads();
#pragma unroll
        for (int half = 0; half < 2; ++half) {
            const int cur = half ? c1 : c0;
            if (cur < 0) continue;
            LAS unsigned char* buf = half ? bufb : bufa;
            const int key0 = cur * 64;
            bool rel = true, msk = true;
            if (MODE == 1) { rel = key0 <= qlo + 31 && key0 + 63 + 512 > qlo; msk = (key0 + 63 > qlo) || (key0 + 512 <= qlo + 31); }
            if (MODE == 2) { const int bit = (int)((selmask >> cur) & 1u); rel = key0 <= qlo + 31 && __any(bit); msk = (key0 + 63 > qlo) || !__all(bit); }
            if (rel) {
                if (msk) tile_compute<2, MODE, true>(buf, qf, o, m, l, key0, t, r, h, selmask);
                else tile_compute<2, MODE, false>(buf, qf, o, m, l, key0, t, r, h, selmask);
            }
        }
        c0 = n0; c1 = n1; bufi ^= 1;
    }
}

DI void diff_block(int b, int hh, int qb, float lam, const bf16* DQ, const bf16* DK, const bf16* DVT, const float* subln, bf16* AO, LAS unsigned char* lds, int wave, int lane, int tid) {
    const int r = lane & 31, h = lane >> 5, qlo = 256 * qb + 32 * wave, t = qlo + r;
    f32x16 o1[4];
    const bf16* Vg = DVT + (size_t)(b * 4 + hh) * 128 * 2048;
    const int ntile = 4 * qb + 4; const unsigned tiles = (ntile >= 32) ? 0xffffffffu : ((1u << ntile) - 1u);
    bf16* orow = AO + (size_t)(b * 2048 + t) * 1024 + hh * 128 + 4 * h;
    float ss = 0.f;
#pragma unroll 1
    for (int mm = 0; mm < 2; ++mm) {
        const size_t slab = ((size_t)((b * 4 + hh) * 2 + mm) * 2048) * 64;
        bf16x8 qf[4]; load_q(qf, DQ + slab + (size_t)t * 64 + 8 * h);
        float m = -INFINITY, l = 0.f;
        zero_o<4>(o1);
        flash_block<4, 0>(DK + slab, Vg, 2048, tiles, lds, qf, o1, m, l, t, qlo, r, h, 0u, tid);
        l += __shfl_xor(l, 32);
        const float inv = (l > 0.f) ? 1.f / l : 0.f;
        if (mm == 0) {
#pragma unroll
            for (int db = 0; db < 4; ++db)
#pragma unroll
                for (int a = 0; a < 4; ++a) {
                    u32x2 w; w.x = pk2(o1[db][4 * a + 0] * inv, o1[db][4 * a + 1] * inv); w.y = pk2(o1[db][4 * a + 2] * inv, o1[db][4 * a + 3] * inv);
                    *(u32x2*)(orow + 32 * db + 8 * a) = w;
                }
        } else {
            const float li = lam * inv;
#pragma unroll
            for (int db = 0; db < 4; ++db)
#pragma unroll
                for (int a = 0; a < 4; ++a) {
                    const u32x2 w = *(const u32x2*)(orow + 32 * db + 8 * a);
                    o1[db][4 * a + 0] = __builtin_bit_cast(float, w.x << 16) - li * o1[db][4 * a + 0];
                    o1[db][4 * a + 1] = __builtin_bit_cast(float, w.x & 0xffff0000u) - li * o1[db][4 * a + 1];
                    o1[db][4 * a + 2] = __builtin_bit_cast(float, w.y << 16) - li * o1[db][4 * a + 2];
                    o1[db][4 * a + 3] = __builtin_bit_cast(float, w.y & 0xffff0000u) - li * o1[db][4 * a + 3];
                    ss += (o1[db][4 * a + 0] * o1[db][4 * a + 0] + o1[db][4 * a + 1] * o1[db][4 * a + 1]) + (o1[db][4 * a + 2] * o1[db][4 * a + 2] + o1[db][4 * a + 3] * o1[db][4 * a + 3]);
                }
        }
    }
    ss += __shfl_xor(ss, 32);
    const float rs = __builtin_amdgcn_rsqf(ss * (1.f / 128.f) + EPS) * 0.8f;
#pragma unroll
    for (int db = 0; db < 4; ++db)
#pragma unroll
        for (int a = 0; a < 4; ++a) {
            const f32x4 g = *(const f32x4*)(subln + 32 * db + 8 * a + 4 * h);
            u32x2 w; w.x = pk2(o1[db][4 * a + 0] * rs * g[0], o1[db][4 * a + 1] * rs * g[1]); w.y = pk2(o1[db][4 * a + 2] * rs * g[2], o1[db][4 * a + 3] * rs * g[3]);
            *(u32x2*)(orow + 32 * db + 8 * a) = w;
        }
}

DI void nsa_block(int b, int g, int c, const bf16* NQ, const bf16* KC, const bf16* VCT, const bf16* KV6, const float* GATES, bf16* AO, LAS unsigned char* lds, int wave, int lane, int tid) {
    const int r = lane & 31, h = lane >> 5, hq = wave >> 1, qs = wave & 1, qlo = 64 * c + 32 * qs, t = qlo + r, bg = b * 2 + g, head = g * 4 + hq;
    const bf16* KCg = KC + (size_t)bg * 128 * 64;
    const bf16* VCg = VCT + (size_t)bg * 64 * 128;
    const size_t kvoff = (size_t)bg * 2048 * 64;
    bf16x8 qf[4]; load_q(qf, NQ + ((size_t)(b * 8 + head) * 2048 + t) * 64 + 8 * h);
    unsigned selmask, uni;
    const unsigned causal = (c >= 31) ? 0xffffffffu : ((2u << c) - 1u);
    if (c >= 16) {
    float imp[16];
    {
        const bf16* KCb = KCg + (size_t)r * 64 + 8 * h;
        f32x16 s[4]; float mx = -INFINITY;
#pragma unroll
        for (int T = 0; T < 4; ++T) {
            s[T] = qk_tile(KCb + (size_t)T * 32 * 64, qf);
            __builtin_amdgcn_sched_barrier(0);
#pragma unroll
            for (int i = 0; i < 16; ++i) { s[T][i] = key_valid<3>(32 * T + crow(i, h), t, 0u) ? s[T][i] : -INFINITY; mx = fmaxf(mx, s[T][i]); }
            __builtin_amdgcn_sched_barrier(0);
        }
        mx = fmaxf(mx, __shfl_xor(mx, 32));
        const float mu = (mx == -INFINITY) ? 0.f : mx;
        float ps = 0.f;
#pragma unroll
        for (int T = 0; T < 4; ++T)
#pragma unroll
            for (int i = 0; i < 16; ++i) { s[T][i] = __builtin_amdgcn_exp2f(s[T][i] - mu); ps += s[T][i]; }
        ps += __shfl_xor(ps, 32);
        const float inv = (ps > 0.f) ? 1.f / ps : 0.f;
        float xs[16];
#pragma unroll
        for (int idx = 0; idx < 16; ++idx) xs[idx] = __shfl_xor(s[idx >> 2][4 * (idx & 3) + 3], 32);
#pragma unroll
        for (int idx = 0; idx < 16; ++idx) {
            const int T = idx >> 2, a = idx & 3;
            const float w = s[T][4 * a] + s[T][4 * a + 1] + s[T][4 * a + 2] + 0.5f * s[T][4 * a + 3];
            const float cprev = (idx > 0) ? xs[idx > 0 ? idx - 1 : 0] : 0.f;
            const float carry = h ? xs[idx] : cprev;
            imp[idx] = (w + 0.5f * carry) * inv;
        }
    }
    LAS float* impx = (LAS float*)(lds + A_IMPX);
    LAS unsigned* misc = (LAS unsigned*)(lds + A_MISC);
#pragma unroll
    for (int idx = 0; idx < 16; ++idx) impx[(wave * 16 + idx) * 64 + lane] = imp[idx];
    if (tid == 0) misc[8] = 0u;
    __syncthreads();
#pragma unroll
    for (int idx = 0; idx < 16; ++idx) imp[idx] = (impx[((0 * 2 + qs) * 16 + idx) * 64 + lane] + impx[((1 * 2 + qs) * 16 + idx) * 64 + lane]) + (impx[((2 * 2 + qs) * 16 + idx) * 64 + lane] + impx[((3 * 2 + qs) * 16 + idx) * 64 + lane]);
    {
        const int cur = t >> 6;
        float val[16], oth[16];
#pragma unroll
        for (int idx = 0; idx < 16; ++idx) { const int j = 2 * idx + h; const bool forced = (j == 0) || (j == cur) || (j == cur - 1);
            val[idx] = forced ? 1e9f : ((j <= cur) ? imp[idx] : -1.f); }
#pragma unroll
        for (int idx = 0; idx < 16; ++idx) oth[idx] = __shfl_xor(val[idx], 32);
        unsigned bits = 0u;
#pragma unroll
        for (int idx = 0; idx < 16; ++idx) {
            const int j = 2 * idx + h; const float v = val[idx]; int rank = 0;
#pragma unroll
            for (int i2 = 0; i2 < 16; ++i2) {
                const int j2 = 2 * i2 + h, j3 = 2 * i2 + 1 - h;
                rank += (val[i2] > v || (val[i2] == v && j2 < j)) ? 1 : 0;
                rank += (oth[i2] > v || (oth[i2] == v && j3 < j)) ? 1 : 0;
                asm volatile("" : "+v"(rank));
            }
            bits |= (rank < 16) ? (1u << j) : 0u;
        }
        selmask = bits | (unsigned)__shfl_xor((int)bits, 32);
    }
    __hip_atomic_fetch_or((LAS unsigned*)&misc[8], selmask, __ATOMIC_RELAXED, __HIP_MEMORY_SCOPE_WORKGROUP);
    __syncthreads();
    uni = misc[8];
    uni = (unsigned)__builtin_amdgcn_readfirstlane((int)uni);
    } else { selmask = causal; uni = causal; }
    const float* gp = GATES + (size_t)(b * 2048 + t) * 24 + head * 3;
    const float g0 = gp[0], g1 = gp[1], g2 = gp[2];
    f32x16 out[2], o[2];
    zero_o<2>(out);
    {
        float m = -INFINITY, l = 0.f; zero_o<2>(o);
        flash_block2<3>(KCg, VCg, 128, 3u, lds, qf, o, m, l, t, qlo, r, h, 0u, tid);
        l += __shfl_xor(l, 32); const float f = (l > 0.f) ? g0 / l : 0.f;
#pragma unroll
        for (int db = 0; db < 2; ++db)
#pragma unroll
            for (int i = 0; i < 16; ++i) out[db][i] += f * o[db][i];
    }
    {
        float m = -INFINITY, l = 0.f; zero_o<2>(o);
        flash_block2<2>(KV6 + 2 * KVSLAB + kvoff, KV6 + 3 * KVSLAB + kvoff, 2048, uni & causal, lds, qf, o, m, l, t, qlo, r, h, selmask, tid);
        l += __shfl_xor(l, 32); const float f = (l > 0.f) ? g1 / l : 0.f;
#pragma unroll
        for (int db = 0; db < 2; ++db)
#pragma unroll
            for (int i = 0; i < 16; ++i) out[db][i] += f * o[db][i];
    }
    {
        float m = -INFINITY, l = 0.f; zero_o<2>(o);
        const unsigned lowm = (c > 8) ? ((1u << (c - 8)) - 1u) : 0u;
        flash_block2<1>(KV6 + 4 * KVSLAB + kvoff, KV6 + 5 * KVSLAB + kvoff, 2048, causal & ~lowm, lds, qf, o, m, l, t, qlo, r, h, 0u, tid);
        l += __shfl_xor(l, 32); const float f = (l > 0.f) ? g2 / l : 0.f;
#pragma unroll
        for (int db = 0; db < 2; ++db)
#pragma unroll
            for (int i = 0; i < 16; ++i) out[db][i] += f * o[db][i];
    }
    bf16* orow = AO + (size_t)(b * 2048 + t) * 1024 + 512 + head * 64 + 4 * h;
#pragma unroll
    for (int db = 0; db < 2; ++db)
#pragma unroll
        for (int a = 0; a < 4; ++a) {
            u32x2 w; w.x = pk2(out[db][4 * a + 0], out[db][4 * a + 1]); w.y = pk2(out[db][4 * a + 2], out[db][4 * a + 3]);
            *(u32x2*)(orow + 32 * db + 8 * a) = w;
        }
}

__global__ void __launch_bounds__(512) mega(Params p) {
    extern __shared__ __attribute__((aligned(16))) unsigned char lds_raw[];
    cg::grid_group grid = cg::this_grid();
    LAS unsigned char* lds = (LAS unsigned char*)lds_raw;
#define FRESH_IDS() int tid = threadIdx.x; asm volatile("" : "+v"(tid)); const int lane = tid & 63, wave = __builtin_amdgcn_readfirstlane(tid >> 6); const int gw = blockIdx.x * 8 + wave; (void)gw; (void)lane; (void)wave;
    const int G = gridDim.x, NGW = G * 8;
    unsigned char* ws = p.ws;
    unsigned* ctl = (unsigned*)(ws + WS_CTL);
    float* ROPE = (float*)(ws + WS_ROPE); float* CBIAS = (float*)(ws + WS_CBIAS); bf16* CW2 = (bf16*)(ws + WS_CW2); bf16* KC = (bf16*)(ws + WS_KC); bf16* VCT = (bf16*)(ws + WS_VCT);
    bf16* CW1 = (bf16*)(ws + WS_CW1); float* SSP = (float*)(ws + WS_SSP); float* GATES = (float*)(ws + WS_GATES);
    bf16* WOUT = (bf16*)(ws + WS_WOUT); bf16* WIN = (bf16*)(ws + WS_WIN); bf16* WGU1 = (bf16*)(ws + WS_WGU1); bf16* WD1 = (bf16*)(ws + WS_WD1); bf16* WGU2 = (bf16*)(ws + WS_WGU2); bf16* WD2 = (bf16*)(ws + WS_WD2);
    bf16* XR = (bf16*)(ws + WS_XR);
    float* RI = (float*)(ws + (52u << 20));
    bf16* XN = (bf16*)(ws + WS_XN); bf16* HD = (bf16*)(ws + WS_HD); bf16* HB = (bf16*)(ws + WS_HB);
    bf16* DQ = (bf16*)(ws + WS_DQ); bf16* DK = (bf16*)(ws + WS_DK); bf16* DVT = (bf16*)(ws + WS_DVT); bf16* NQ = (bf16*)(ws + WS_NQ); bf16* KV6 = (bf16*)(ws + WS_KV6);
    const float* x = p.in[0]; float* out = p.out;

    if (threadIdx.x < 64) ((LAS unsigned*)(lds + 131072))[threadIdx.x] = 0u;
    __syncthreads();
    XcdBarrier xbar = xcd_barrier_post((unsigned*)(ws + WS_BAR), (volatile LAS unsigned*)(lds + 131072));
#define GRID_SYNC() xcd_barrier(xbar)
    if (p.out == nullptr) grid.sync();
    {
        FRESH_IDS();
        if (blockIdx.x == 0 && tid < 64) ctl[tid] = 0u;
        LAS float* scr = (LAS float*)(lds + wave * 8448);
        constexpr int I_GU = 16 * 88, I_DN = 44 * 32, I_IN = 16 * 96, I_OUT = 16 * 32, I_C1 = 32 * 8, I_C2 = 4 * 2;
        constexpr int NITEMS = 4 * I_GU + 2 * I_DN + I_IN + I_OUT + 2 * I_C1 + 2 * I_C2;
        for (int it = gw; it < NITEMS; it += NGW) {
            int q = it;
            if (q < 4 * I_GU) {
                const int which = q / I_GU; q -= which * I_GU; const int kb = q / 88, nb = q % 88, n0 = 32 * nb;
                const float* W = p.in[which == 0 ? 2 : which == 1 ? 3 : which == 2 ? 22 : 23];
                bf16* dst = (which < 2) ? WGU1 : WGU2;
                transpose_item(W, 1024, FF, dst, 256 * (n0 >> 7) + (n0 & 127) + ((which & 1) ? 128 : 0), scr, 64 * kb, n0, lane, p.in[which < 2 ? 1 : 21]);
                continue;
            }
            q -= 4 * I_GU;
            if (q < 2 * I_DN) { const int which = q / I_DN; q -= which * I_DN; const int kb = q / 32, nb = q % 32;
                transpose_item(p.in[which ? 24 : 4], FF, 1024, which ? WD2 : WD1, 32 * nb, scr, 64 * kb, 32 * nb, lane); continue; }
            q -= 2 * I_DN;
            if (q < I_IN) { const int kb = q / 96, nb = q % 96; transpose_item(p.in[7], 1024, NIN, WIN, 32 * nb, scr, 64 * kb, 32 * nb, lane, p.in[6]); continue; }
            q -= I_IN;
            if (q < I_OUT) { const int kb = q / 32, nb = q % 32; transpose_item(p.in[19], 1024, 1024, WOUT, 32 * nb, scr, 64 * kb, 32 * nb, lane); continue; }
            q -= I_OUT;
            if (q < 2 * I_C1) { const int which = q / I_C1; q -= which * I_C1; const int kb = q / 8, nb = q % 8;
                transpose_item<true>(p.in[which ? 17 : 14], 2048, 256, CW1 + (size_t)which * 256 * 2048, 32 * nb, scr, 64 * kb, 32 * nb, lane); continue; }
            q -= 2 * I_C1;
            { const int which = q / I_C2; q -= which * I_C2; const int kb = q / 2, nb = q % 2;
              transpose_item(p.in[which ? 18 : 15], 256, 64, CW2 + (size_t)which * 64 * 256, 32 * nb, scr, 64 * kb, 32 * nb, lane); }
        }
        for (int i = blockIdx.x * 512 + tid; i < 2048 * 8; i += G * 512) {
            const int tt = i >> 3, e = i & 7;
            const double inv = exp2(-(double)e * (18.931568569324174 / 8.0));
            const double xr = (double)tt * inv * 0.15915494309189535;
            const double fr = xr - rint(xr);
            const float ang = (float)(fr * 6.283185307179586);
            ROPE[tt * 16 + e] = cosf(ang); ROPE[tt * 16 + 8 + e] = sinf(ang);
        }
        if ((int)blockIdx.x >= G - 16) {
            const int j = (G - 1) - (int)blockIdx.x, kv = j >> 3, sl = (j & 7) * 8 + wave;
            const float* pe = p.in[kv ? 16 : 13] + sl * 32; const float* w1 = p.in[kv ? 17 : 14] + (size_t)sl * 32 * 256;
            f32x4 a = {0.f, 0.f, 0.f, 0.f};
#pragma unroll
            for (int k = 0; k < 32; ++k) { const float pv = pe[k]; const f32x4 w = ((const f32x4*)(w1 + (size_t)k * 256))[lane]; a += pv * w; }
            ((f32x4*)(CBIAS + 1024 + (size_t)(kv * 64 + sl) * 256))[lane] = a;
        }
        rows_phase<false, 0, 0, true>(x, nullptr, nullptr, nullptr, 0.f, nullptr, nullptr, XN, RI, gw, NGW, lane);
    }
    GRID_SYNC();

#ifndef ONLY_ATT
#ifdef PROBE_SYNC
    for (int rep = 0; rep < 10; ++rep) GRID_SYNC();
#endif
#ifdef PROBE_P1
    for (int rep = 0; rep < 2; ++rep)
#endif
    { pg8::Gemm g{XN, WGU1, MROWS, NGU, DM}; pg8::StaticOrder S; S.init(MROWS, NGU, G, (int)blockIdx.x); pg8::EpiSwiglu E{HB, FF};
      pg8::gemm_phase<pg8::EpiSwiglu, pg8::StaticOrder, PG8_ALIGN_SW, true>(lds, g, S, E); }
    GRID_SYNC();
#ifdef PROBE_P2
    for (int rep = 0; rep < 2; ++rep)
#endif
    { pg8::Gemm g{HB, WD1, MROWS, DM, FF}; pg8::StaticOrder S; S.init(MROWS, DM, G, (int)blockIdx.x); pg8::EpiStoreSS E{HD, SSP};
      pg8::gemm_phase<pg8::EpiStoreSS, pg8::StaticOrder, true, true>(lds, g, S, E); }
    GRID_SYNC();
#ifdef PROBE_P3
    for (int rep = 0; rep < 2; ++rep)
#endif
    { FRESH_IDS();
      if (blockIdx.x == 0) { float s = 0.f; const float* pp = CBIAS + 1024 + (size_t)((tid >> 8) * 64) * 256 + (tid & 255);
#pragma unroll 16
          for (int q = 0; q < 64; ++q) s += pp[q * 256];
          CBIAS[tid] = s; }
      rows_phase<true, 1, 0, true>(XN, HD, SSP, p.in[5], 0.5f, nullptr, nullptr, XN, RI, gw, NGW, lane); }
    GRID_SYNC();
#ifdef PROBE_P4
    for (int rep = 0; rep < 2; ++rep)
#endif
    { pg8::Gemm g{XN, WIN, MROWS, NINP, DM}; pg8::StaticOrder S; S.init(MROWS, NINP, G, (int)blockIdx.x); pg8::EpiWin E{DQ, DK, DVT, NQ, KV6, GATES, ROPE};
      pg8::gemm_phase<pg8::EpiWin, pg8::StaticOrder, true, true>(lds, g, S, E); }
    GRID_SYNC();
#ifndef SKIP_CMP
#ifdef PROBE_P5
    for (int rep = 0; rep < 2; ++rep)
#endif
    { FRESH_IDS(); for (int u = blockIdx.x; u < 256; u += G) compress_unit(u, KV6, CW1, CBIAS, CW2, KC, VCT, lds, wave, lane, tid); }
#endif
    GRID_SYNC();
#endif
    {
        FRESH_IDS();
        float lam;
        { const float a = p.in[8][lane] * p.in[9][lane], c = p.in[10][lane] * p.in[11][lane];
          lam = __expf(wave_sum(a)) - __expf(wave_sum(c)) + 0.2f; }
        LAS unsigned* misc = (LAS unsigned*)(lds + A_MISC);
#ifdef PROBE_P6
        for (int rep = 0; rep < 2; ++rep)
#else
        const int rep = 0;
#endif
        {
#ifndef SKIP_DIFF
        for (;;) {
            __syncthreads();
            if (tid == 0) misc[0] = atomicAdd(ctl + 8 * rep, 1u);
            __syncthreads();
            const int u = __builtin_amdgcn_readfirstlane((int)misc[0]);
            if (u >= 512) break;
            int tidu = tid; asm volatile("" : "+v"(tidu));
            const int laneu = tidu & 63, waveu = __builtin_amdgcn_readfirstlane(tidu >> 6);
            const int idx = u & 63;
            diff_block(idx >> 2, idx & 3, 7 - (u >> 6), lam, DQ, DK, DVT, p.in[12], XR, lds, waveu, laneu, tidu);
        }
#endif
#ifndef SKIP_NSA
        for (;;) {
            __syncthreads();
            if (tid == 0) misc[0] = atomicAdd(ctl + 8 * rep + 4, 1u);
            __syncthreads();
            const int u = __builtin_amdgcn_readfirstlane((int)misc[0]);
            if (u >= 1024) break;
            int tidu = tid; asm volatile("" : "+v"(tidu));
            const int laneu = tidu & 63, waveu = __builtin_amdgcn_readfirstlane(tidu >> 6);
            const int idx = u & 31;
            nsa_block(idx >> 1, idx & 1, 31 - (u >> 5), NQ, KC, VCT, KV6, GATES, XR, lds, waveu, laneu, tidu);
        }
#endif
        }
    }
    GRID_SYNC();
#ifndef ONLY_ATT
    { pg8::Gemm g{XR, WOUT, MROWS, DM, DM}; pg8::StaticOrder S; S.init(MROWS, DM, G, (int)blockIdx.x); pg8::EpiStoreSS E{HD, SSP};
      pg8::gemm_phase<pg8::EpiStoreSS, pg8::StaticOrder, true, true>(lds, g, S, E); }
    GRID_SYNC();
    { FRESH_IDS(); rows_phase<true, 1, 0, true>(XN, HD, SSP, p.in[20], 1.0f, nullptr, nullptr, XN, RI, gw, NGW, lane); }
    GRID_SYNC();
    { pg8::Gemm g{XN, WGU2, MROWS, NGU, DM}; pg8::StaticOrder S; S.init(MROWS, NGU, G, (int)blockIdx.x); pg8::EpiSwiglu E{HB, FF};
      pg8::gemm_phase<pg8::EpiSwiglu, pg8::StaticOrder, PG8_ALIGN_SW, true>(lds, g, S, E); }
    GRID_SYNC();
    { pg8::Gemm g{HB, WD2, MROWS, DM, FF}; pg8::StaticOrder S; S.init(MROWS, DM, G, (int)blockIdx.x); pg8::EpiStoreSS E{HD, SSP};
      pg8::gemm_phase<pg8::EpiStoreSS, pg8::StaticOrder, true, true>(lds, g, S, E); }
    GRID_SYNC();
    { FRESH_IDS(); rows_phase<true, 1, 2, false>(XN, HD, SSP, p.in[25], 0.5f, out, nullptr, nullptr, RI, gw, NGW, lane); }
#endif
}

extern "C" void kernel_launch(void* const* d_in, const int* in_sizes, int n_in, void* d_out, int out_size, void* d_ws, size_t ws_size, hipStream_t stream) {
    static int grid_blocks = 0;
    if (!grid_blocks) {
        if (n_in != 26 || out_size != MROWS * DM || ws_size < WS_END) { fprintf(stderr, "kernel_launch: unexpected shapes n_in %d out %d ws %zu\n", n_in, out_size, ws_size); grid_blocks = -1; return; }
        int dev = 0, cus = 0, per_cu = 0;
        (void)hipGetDevice(&dev);
        (void)hipDeviceGetAttribute(&cus, hipDeviceAttributeMultiprocessorCount, dev);
        (void)hipFuncSetAttribute((const void*)mega, hipFuncAttributeMaxDynamicSharedMemorySize, LDS_BYTES);
        (void)hipOccupancyMaxActiveBlocksPerMultiprocessor(&per_cu, (const void*)mega, 512, LDS_BYTES);
        if (per_cu < 1) per_cu = 1;
        grid_blocks = cus * per_cu;
    }
    if (grid_blocks < 0) return;
    if (hipMemsetAsync((char*)d_ws + WS_BAR, 0, XCD_BAR_WORDS * sizeof(unsigned), stream) != hipSuccess) { fprintf(stderr, "kernel_launch: memset of the barrier words failed\n"); return; }
    Params p{};
    for (int i = 0; i < 26; ++i) p.in[i] = (const float*)d_in[i];
    p.out = (float*)d_out; p.ws = (unsigned char*)d_ws;
    void* args[] = {&p};
    hipError_t e = hipLaunchCooperativeKernel((void*)mega, dim3(grid_blocks), dim3(512), args, LDS_BYTES, stream);
    if (e != hipSuccess) fprintf(stderr, "cooperative launch failed: %s (grid %d)\n", hipGetErrorString(e), grid_blocks);
}
```
